# Optimizing an MI355X kernel written in HIP

```python
import jax, jax.numpy as jnp
from jax import lax
import numpy as np

D_MODEL = 1024
BATCH = 16
SEQ = 2048
DEPTH = 4

HEAD_DIM = 64
N_HEADS = D_MODEL // HEAD_DIM
N_HEADS_SB = N_HEADS // 4
N_HEADS_DIL = (3 * N_HEADS) // 8
N_HEADS_FOX = N_HEADS - N_HEADS_SB - N_HEADS_DIL
D_MIX = N_HEADS * HEAD_DIM
N_IN = 3 * D_MIX + N_HEADS_FOX
DIL_PATTERNS = ((128, 1), (512, 4), (2048, 16))
Q_BLOCK = 128
ROPE_THETA = 10000.0
N_EXPERTS = 32
TOP_K = 4
D_FF = D_MODEL
SWIGLU_LIMIT = 7.0
SWIGLU_ALPHA = 1.702
MOE_BLOCK = 128
N_MOD = 6
EPS = 1e-6

kernel_name = "hybrid_sb_dilated_fox_moe_adaln"


def _rms(x):
    xf = x.astype(jnp.float32)
    return (xf * lax.rsqrt(jnp.mean(xf * xf, axis=-1, keepdims=True) + EPS)).astype(x.dtype)


def rmsnorm(x, g):
    return _rms(x) * g


def apply_rope(t, positions):
    dh = t.shape[-1]
    inv_freq = ROPE_THETA ** (-jnp.arange(0, dh, 2, dtype=jnp.float32) / dh)
    ang = positions.astype(jnp.float32)[:, None, :, None] * inv_freq
    cos, sin = jnp.cos(ang), jnp.sin(ang)
    tf = t.astype(jnp.float32)
    t1, t2 = tf[..., : dh // 2], tf[..., dh // 2:]
    return jnp.concatenate([t1 * cos - t2 * sin, t2 * cos + t1 * sin], axis=-1).astype(t.dtype)


def _to_query_blocks(t):
    b, h, s = t.shape[:3]
    nq = s // Q_BLOCK
    t = t.reshape((b, h, nq, Q_BLOCK) + t.shape[3:])
    return jnp.moveaxis(t, 2, 0)


def _from_query_blocks(t):
    nq, b, h, qb, dh = t.shape
    return jnp.moveaxis(t, 0, 2).reshape(b, h, nq * qb, dh)


def stick_breaking_attention(q, k, v):
    b, h, s, dh = q.shape
    scale = dh ** -0.5
    key_pos = jnp.arange(s)

    def block(args):
        q_blk, start = args
        z = jnp.einsum('bhqd,bhkd->bhqk', q_blk, k, preferred_element_type=jnp.float32) * scale
        qpos = start + jnp.arange(Q_BLOCK)
        mask = key_pos[None, :] < qpos[:, None]
        log_not = jnp.where(mask, jax.nn.log_sigmoid(-z), 0.0)
        between = lax.cumsum(log_not, axis=3, reverse=True) - log_not
        weights = jnp.where(mask, jnp.exp(jax.nn.log_sigmoid(z) + between), 0.0)
        return jnp.einsum('bhqk,bhkd->bhqd', weights.astype(v.dtype), v)

    starts = jnp.arange(s // Q_BLOCK, dtype=jnp.int32) * Q_BLOCK
    return _from_query_blocks(lax.map(block, (_to_query_blocks(q), starts)))


def forgetting_attention(q, k, v, log_f):
    b, h, s, dh = q.shape
    scale = dh ** -0.5
    key_pos = jnp.arange(s)
    cum = jnp.cumsum(log_f, axis=-1)

    def block(args):
        q_blk, cum_q, start = args
        logits = jnp.einsum('bhqd,bhkd->bhqk', q_blk, k, preferred_element_type=jnp.float32) * scale
        logits = logits + cum_q[..., :, None] - cum[..., None, :]
        qpos = start + jnp.arange(Q_BLOCK)
        mask = key_pos[None, :] <= qpos[:, None]
        p = jax.nn.softmax(jnp.where(mask, logits, -jnp.inf), axis=-1)
        return jnp.einsum('bhqk,bhkd->bhqd', p.astype(v.dtype), v)

    starts = jnp.arange(s // Q_BLOCK, dtype=jnp.int32) * Q_BLOCK
    return _from_query_blocks(lax.map(block, (_to_query_blocks(q), _to_query_blocks(cum), starts)))


def banded_window_attention(q, k, v, window):
    *lead, L, dh = q.shape
    nlead = len(lead)
    blk = window
    nb = -(-L // blk)
    pad = nb * blk - L
    scale = dh ** -0.5
    qp = jnp.pad(q, [(0, 0)] * nlead + [(0, pad), (0, 0)])
    kp = jnp.pad(k, [(0, 0)] * nlead + [(blk, pad), (0, 0)])
    vp = jnp.pad(v, [(0, 0)] * nlead + [(blk, pad), (0, 0)])
    qb = qp.reshape(*lead, nb, blk, dh)
    kb = kp.reshape(*lead, nb + 1, blk, dh)
    vb = vp.reshape(*lead, nb + 1, blk, dh)
    kcat = jnp.concatenate([kb[..., :-1, :, :], kb[..., 1:, :, :]], axis=-2)
    vcat = jnp.concatenate([vb[..., :-1, :, :], vb[..., 1:, :, :]], axis=-2)
    logits = jnp.einsum('...nqd,...nkd->...nqk', qb, kcat, preferred_element_type=jnp.float32) * scale
    dist = (jnp.arange(blk)[:, None] + blk) - jnp.arange(2 * blk)[None, :]
    in_band = (dist >= 0) & (dist <= window)
    not_front = (jnp.arange(nb)[:, None, None] > 0) | (jnp.arange(2 * blk)[None, None, :] >= blk)
    mask = in_band[None] & not_front
    logits = jnp.where(mask, logits, -jnp.inf)
    m = jnp.max(logits, axis=-1, keepdims=True)
    p = jnp.exp(logits - m)
    denom = jnp.sum(p, axis=-1)
    o = jnp.einsum('...nqk,...nkd->...nqd', p.astype(v.dtype), vcat).astype(jnp.float32) / denom[..., None]
    lse = m[..., 0] + jnp.log(denom)
    o = o.reshape(*lead, nb * blk, dh)[..., :L, :]
    lse = lse.reshape(*lead, nb * blk)[..., :L]
    return o, lse


def _stride_split(t, dil):
    b, h, s, dh = t.shape
    return t.reshape(b, h, s // dil, dil, dh).transpose(0, 1, 3, 2, 4)


def dilated_attention(q, k, v):
    b, h, s, dh = q.shape
    outs, lses = [], []
    for window, dil in DIL_PATTERNS:
        o, lse = banded_window_attention(_stride_split(q, dil), _stride_split(k, dil),
                                         _stride_split(v, dil), window // dil)
        outs.append(o.transpose(0, 1, 3, 2, 4).reshape(b, h, s, dh))
        lses.append(lse.transpose(0, 1, 3, 2).reshape(b, h, s))
    alpha = jax.nn.softmax(jnp.stack(lses, axis=0), axis=0)
    out = alpha[0][..., None] * outs[0]
    for i in range(1, len(DIL_PATTERNS)):
        out = out + alpha[i][..., None] * outs[i]
    return out.astype(q.dtype)


def hybrid_mixer(h, positions, w_in, b_forget, g_mix, w_out):
    b, s, _ = h.shape
    proj = h @ w_in
    q = proj[..., :D_MIX]
    k = proj[..., D_MIX:2 * D_MIX]
    v = proj[..., 2 * D_MIX:3 * D_MIX]
    f_logit = proj[..., 3 * D_MIX:]

    def heads(t):
        return t.reshape(b, s, N_HEADS, HEAD_DIM).transpose(0, 2, 1, 3)

    q, k, v = heads(q), heads(k), heads(v)
    i1 = N_HEADS_SB
    i2 = N_HEADS_SB + N_HEADS_DIL
    o_sb = stick_breaking_attention(q[:, :i1], k[:, :i1], v[:, :i1])
    o_dil = dilated_attention(apply_rope(q[:, i1:i2], positions), apply_rope(k[:, i1:i2], positions), v[:, i1:i2])
    log_f = jax.nn.log_sigmoid(f_logit.astype(jnp.float32) + b_forget.astype(jnp.float32)).transpose(0, 2, 1)
    o_fox = forgetting_attention(q[:, i2:], k[:, i2:], v[:, i2:], log_f)

    def merge(o):
        return _rms(o.transpose(0, 2, 1, 3).reshape(b, s, -1))

    o = jnp.concatenate([merge(o_sb), merge(o_dil), merge(o_fox)], axis=-1) * g_mix
    return o @ w_out


def moe_ffn(h, w_router, b_router, w_gu, b_gu, w_dn, b_dn):
    b, s, d = h.shape
    n = b * s
    xt = h.reshape(n, d)
    logits = (xt @ w_router).astype(jnp.float32) + b_router.astype(jnp.float32)
    top_val, top_idx = lax.top_k(logits, TOP_K)
    gates = jax.nn.softmax(top_val, axis=-1)
    n_assign = n * TOP_K
    flat_e = top_idx.reshape(-1).astype(jnp.int32)
    flat_tok = jnp.repeat(jnp.arange(n, dtype=jnp.int32), TOP_K)
    flat_g = gates.reshape(-1)
    order = jnp.argsort(flat_e)
    se, st, sg = flat_e[order], flat_tok[order], flat_g[order]
    counts = jnp.bincount(flat_e, length=N_EXPERTS).astype(jnp.int32)
    starts = jnp.cumsum(counts) - counts
    pcounts = (counts + MOE_BLOCK - 1) // MOE_BLOCK * MOE_BLOCK
    pends = jnp.cumsum(pcounts)
    pstarts = pends - pcounts
    ppos = pstarts[se] + (jnp.arange(n_assign, dtype=jnp.int32) - starts[se])
    nblk = -(-(n_assign + N_EXPERTS * (MOE_BLOCK - 1)) // MOE_BLOCK)
    cap = nblk * MOE_BLOCK
    row_tok = jnp.zeros((cap,), jnp.int32).at[ppos].set(st)
    row_gate = jnp.zeros((cap,), jnp.float32).at[ppos].set(sg)
    blk_e = jnp.minimum(jnp.searchsorted(pends, jnp.arange(nblk, dtype=jnp.int32) * MOE_BLOCK, side='right'),
                        N_EXPERTS - 1).astype(jnp.int32)

    def step(y, args):
        tok, g, e = args
        xb = xt[tok]
        gu = xb @ w_gu[e] + b_gu[e]
        gate, up = gu[:, :D_FF], gu[:, D_FF:]
        gate = jnp.minimum(gate, SWIGLU_LIMIT)
        up = jnp.clip(up, -SWIGLU_LIMIT, SWIGLU_LIMIT)
        act = (up + 1) * (gate * jax.nn.sigmoid(SWIGLU_ALPHA * gate))
        out = act @ w_dn[e] + b_dn[e]
        return y.at[tok].add((g[:, None] * out).astype(y.dtype)), None

    y, _ = lax.scan(step, jnp.zeros_like(xt),
                    (row_tok.reshape(nblk, MOE_BLOCK), row_gate.reshape(nblk, MOE_BLOCK), blk_e))
    return y.reshape(b, s, d)


def setup_inputs(seed: int = 0) -> dict:
    key = jax.random.key(seed)
    ks = jax.random.split(key, 20)

    def nrm(k, shape, scale):
        return jax.random.normal(k, shape, jnp.float32) * scale

    D = D_MODEL
    x = nrm(ks[0], (BATCH, SEQ, D), 1.0)
    c = nrm(ks[1], (BATCH, D), 1.0)
    positions = (jnp.arange(SEQ, dtype=jnp.int32)[None, :]
                 + jax.random.randint(ks[2], (BATCH, 1), 0, 4096, dtype=jnp.int32))
    w_mod = nrm(ks[3], (DEPTH, D, N_MOD * D), 0.5 * D ** -0.5)
    b_mod = nrm(ks[4], (DEPTH, N_MOD * D), 0.02)
    g_attn = 1.0 + nrm(ks[5], (DEPTH, D), 0.02)
    w_in = nrm(ks[6], (DEPTH, D, N_IN), D ** -0.5)
    b_forget = jax.random.uniform(ks[7], (DEPTH, N_HEADS_FOX), jnp.float32, 1.0, 5.0)
    g_mix = 1.0 + nrm(ks[8], (DEPTH, D_MIX), 0.02)
    w_out = nrm(ks[9], (DEPTH, D_MIX, D), D_MIX ** -0.5)
    g_ffn = 1.0 + nrm(ks[10], (DEPTH, D), 0.02)
    w_router = nrm(ks[11], (DEPTH, D, N_EXPERTS), D ** -0.5)
    b_router = nrm(ks[12], (DEPTH, N_EXPERTS), 0.01)
    w_gate_up = nrm(ks[13], (DEPTH, N_EXPERTS, D, 2 * D_FF), D ** -0.5)
    b_gate_up = nrm(ks[14], (DEPTH, N_EXPERTS, 2 * D_FF), 0.02)
    w_down = nrm(ks[15], (DEPTH, N_EXPERTS, D_FF, D), D_FF ** -0.5)
    b_down = nrm(ks[16], (DEPTH, N_EXPERTS, D), 0.02)
    g_final = 1.0 + nrm(ks[17], (D,), 0.02)
    return {"x": x, "c": c, "positions": positions, "w_mod": w_mod, "b_mod": b_mod,
            "g_attn": g_attn, "w_in": w_in, "b_forget": b_forget, "g_mix": g_mix, "w_out": w_out,
            "g_ffn": g_ffn, "w_router": w_router, "b_router": b_router, "w_gate_up": w_gate_up,
            "b_gate_up": b_gate_up, "w_down": w_down, "b_down": b_down, "g_final": g_final}


def reference(x, c, positions, w_mod, b_mod, g_attn, w_in, b_forget, g_mix, w_out, g_ffn,
              w_router, b_router, w_gate_up, b_gate_up, w_down, b_down, g_final):
    c_act = jax.nn.silu(c)
    for layer in range(DEPTH):
        mod = (c_act @ w_mod[layer] + b_mod[layer])[:, None, :]
        sh1, sc1, ga1, sh2, sc2, ga2 = jnp.split(mod, N_MOD, axis=-1)
        h = rmsnorm(x, g_attn[layer]) * (1 + sc1) + sh1
        x = x + ga1 * hybrid_mixer(h, positions, w_in[layer], b_forget[layer], g_mix[layer], w_out[layer])
        h = rmsnorm(x, g_ffn[layer]) * (1 + sc2) + sh2
        x = x + ga2 * moe_ffn(h, w_router[layer], b_router[layer], w_gate_up[layer], b_gate_up[layer],
                              w_down[layer], b_down[layer])
    return rmsnorm(x, g_final)
```

```cpp
#include <hip/hip_runtime.h>
#include <cstdio>
#include <cstdint>
#include <cmath>

#ifndef N_LAUNCHES
#define N_LAUNCHES 1
#endif
#ifndef PH_MASK
#define PH_MASK 0xFFFF
#endif
#define EN(k) ((PH_MASK >> (k)) & 1)
#ifndef ATT_MASK
#define ATT_MASK 7
#endif
#ifndef MOE_FP8
#define MOE_FP8 1
#endif
#ifndef X16
#define X16 1
#endif
#ifndef SLOT_OUT
#define SLOT_OUT 1
#endif
#ifndef FUSE_ONORM
#define FUSE_ONORM 1
#endif
#ifndef QKV_FP8
#define QKV_FP8 2
#endif
#ifndef OUT_FP8
#define OUT_FP8 1
#endif
#ifndef REP_DRYQKV
#define REP_DRYQKV 0
#endif
#ifndef REP_DRYG1
#define REP_DRYG1 0
#endif
#ifndef REP_DRYG2
#define REP_DRYG2 0
#endif
#ifndef REP_ONORM
#define REP_ONORM 0
#endif
#ifndef REP_OUT
#define REP_OUT 0
#endif
#ifndef REP_COMB
#define REP_COMB 0
#endif
#ifndef REP_ROUTE
#define REP_ROUTE 0
#endif
#ifndef REP_ATT_MASK
#define REP_ATT_MASK 7
#endif
#ifndef REP_ATT
#define REP_ATT 0
#endif
#ifndef REP_QKV
#define REP_QKV 0
#endif
#ifndef REP_G1
#define REP_G1 0
#endif
#ifndef REP_G2
#define REP_G2 0
#endif
#ifndef REP_PRO
#define REP_PRO 0
#endif

#define LAS __attribute__((address_space(3)))
#define GAS __attribute__((address_space(1)))
typedef unsigned short bf16_t;
typedef short bf16x8 __attribute__((ext_vector_type(8)));
typedef short s16x4 __attribute__((ext_vector_type(4)));
typedef float f32x2 __attribute__((ext_vector_type(2)));
typedef float f32x4 __attribute__((ext_vector_type(4)));
typedef float f32x4u __attribute__((ext_vector_type(4), aligned(4)));
typedef float f32x16 __attribute__((ext_vector_type(16)));
typedef unsigned u32x2 __attribute__((ext_vector_type(2)));
typedef unsigned u32x4 __attribute__((ext_vector_type(4)));
typedef int v8i32 __attribute__((ext_vector_type(8)));
typedef __bf16 bf16x2_t __attribute__((ext_vector_type(2)));
typedef GAS unsigned gu32;

constexpr int DM = 1024, NB = 16, SEQ = 2048, NTOK = NB * SEQ, DEPTH = 4, NIN = 3078, NE = 32, NMOD = 6;
constexpr float LOG2E = 1.4426950408889634f;
constexpr float QSCALE = 0.125f * LOG2E;
constexpr float EPS = 1e-6f;
constexpr int NWAVES = 8, NTHREADS = 512;

constexpr size_t MiB = 1u << 20;
constexpr size_t WS_CTL = 0, CTL_ZERO_BYTES = 1 * MiB;
constexpr size_t WS_SS = 2 * MiB;
constexpr size_t WS_MOD = 4 * MiB;
constexpr size_t WS_ROPE = 8 * MiB;
constexpr size_t WS_LF2 = 16 * MiB;
constexpr size_t WS_TOPG = 17 * MiB;
constexpr size_t WS_WRT = 18 * MiB;
constexpr size_t WS_LIST = 20 * MiB;
constexpr size_t WS_POSE = 24 * MiB;
constexpr size_t WS_WIN = 32 * MiB;
constexpr size_t WS_WOUT = 56 * MiB;
constexpr size_t WS_WGU = 64 * MiB;
constexpr size_t WS_WDN = 576 * MiB;
constexpr size_t WS_H = 832 * MiB;
constexpr size_t WS_Q = 896 * MiB, WS_K = 960 * MiB, WS_V = 1024 * MiB, WS_O = 1088 * MiB;
constexpr size_t WS_ACT = 1152 * MiB;
constexpr size_t WS_OUTB = 1424 * MiB;
constexpr size_t WS_H8 = 1680 * MiB;
constexpr size_t WS_WIN8 = 1744 * MiB;
constexpr size_t WS_X16 = 1760 * MiB;
constexpr size_t WS_END = 1824 * MiB;
constexpr int CW_BAR = 4096;
constexpr int CW_GCNT = 16384;
#ifndef EPI_CONV
#define EPI_CONV 1
#endif
constexpr int CW_CONV = 24576;
constexpr int CW_AQ = 20480;

constexpr int RING_BYTES = 131072;
constexpr int MISC_OFF = RING_BYTES;
constexpr int LDS_BYTES = 147456;
constexpr int MO_BAR = 0, MO_Q = 16, MO_VOTE = 64, MO_SCAN = 128, MO_PRE = 256, MO_CNT = 512, MO_HIST = 1024, MO_BASE = 1152, MO_ENT = 2048, MO_T2E = 4096, MO_RF = 8192;

__device__ __forceinline__ int lane_id() { int l; asm volatile("v_mbcnt_lo_u32_b32 %0, -1, 0\n\tv_mbcnt_hi_u32_b32 %0, -1, %0" : "=v"(l)); return l; }
#ifndef DBG_SHFL
#define DBG_SHFL 0
#endif
#define DPP_F(v, ctrl, rmask) __builtin_bit_cast(float, __builtin_amdgcn_update_dpp(0, __builtin_bit_cast(int, (float)(v)), (ctrl), (rmask), 0xf, true))
__device__ __forceinline__ float wave_sum(float v) {
    if (DBG_SHFL & 1) { for (int o = 1; o < 64; o <<= 1) v += __shfl_xor(v, o); return v; }
    v += DPP_F(v, 0xB1, 0xf); v += DPP_F(v, 0x4E, 0xf); v += DPP_F(v, 0x141, 0xf); v += DPP_F(v, 0x140, 0xf);
    v += DPP_F(v, 0x142, 0xa); v += DPP_F(v, 0x143, 0xc);
    return __builtin_bit_cast(float, __builtin_amdgcn_readlane(__builtin_bit_cast(int, v), 63));
}
#define DPP_FM(v, ctrl, rmask) __builtin_bit_cast(float, __builtin_amdgcn_update_dpp(__builtin_bit_cast(int, (float)(v)), __builtin_bit_cast(int, (float)(v)), (ctrl), (rmask), 0xf, false))
__device__ __forceinline__ float wave_max(float v) {
    v = fmaxf(v, DPP_FM(v, 0xB1, 0xf)); v = fmaxf(v, DPP_FM(v, 0x4E, 0xf)); v = fmaxf(v, DPP_FM(v, 0x141, 0xf)); v = fmaxf(v, DPP_FM(v, 0x140, 0xf));
    v = fmaxf(v, DPP_FM(v, 0x142, 0xa)); v = fmaxf(v, DPP_FM(v, 0x143, 0xc));
    return __builtin_bit_cast(float, __builtin_amdgcn_readlane(__builtin_bit_cast(int, v), 63));
}
__device__ __forceinline__ float half_max(float v) {
    if (DBG_SHFL & 2) { for (int o = 1; o < 32; o <<= 1) v = fmaxf(v, __shfl_xor(v, o)); return v; }
    v = fmaxf(v, DPP_FM(v, 0xB1, 0xf)); v = fmaxf(v, DPP_FM(v, 0x4E, 0xf)); v = fmaxf(v, DPP_FM(v, 0x141, 0xf)); v = fmaxf(v, DPP_FM(v, 0x140, 0xf));
    return fmaxf(v, __builtin_bit_cast(float, __builtin_amdgcn_ds_swizzle(__builtin_bit_cast(int, v), 0x401F)));
}
__device__ __forceinline__ float xhalf_get(float v, int lane) { return __builtin_bit_cast(float, __builtin_amdgcn_ds_bpermute((lane ^ 32) << 2, __builtin_bit_cast(int, v))); }
__device__ __forceinline__ float xhalf_sum(float v, int lane) { return v + xhalf_get(v, lane); }
__device__ __forceinline__ unsigned pk2(float lo, float hi) { f32x2 v = {lo, hi}; bf16x2_t b = __builtin_convertvector(v, bf16x2_t); return __builtin_bit_cast(unsigned, b); }
__device__ __forceinline__ unsigned pk4_fp8(float a, float b, float c, float d) { int p = __builtin_amdgcn_cvt_pk_fp8_f32(a, b, 0, false); p = __builtin_amdgcn_cvt_pk_fp8_f32(c, d, p, true); return (unsigned)p; }
__device__ __forceinline__ float bf_lo(unsigned u) { return __uint_as_float(u << 16); }
__device__ __forceinline__ float bf_hi(unsigned u) { return __uint_as_float(u & 0xffff0000u); }
__device__ __forceinline__ float fexp2(float x) { return __builtin_amdgcn_exp2f(x); }
__device__ __forceinline__ float flog2(float x) { return __builtin_amdgcn_logf(x); }
__device__ __forceinline__ float frcp(float x) { return __builtin_amdgcn_rcpf(x); }
__device__ __forceinline__ float frsq(float x) { return __builtin_amdgcn_rsqf(x); }

#define XB_TMO      128
#define XB_XCNT(j)  (256  + 64 * (j))
#define XB_XSUB(j)  (1280 + 64 * (j))
#define XB_XGEN(j)  (2304 + 64 * (j))
#define XB_TOP      3328
#define XB_TOPGEN   3392
#define XCD_BAR_WORDS 3456
#define XB_SPIN_CAP (1u << 22)
__device__ __forceinline__ unsigned xb_ld(unsigned* p)              { return __hip_atomic_load(p, __ATOMIC_RELAXED, __HIP_MEMORY_SCOPE_AGENT); }
__device__ __forceinline__ unsigned xb_add(unsigned* p, unsigned v) { return __hip_atomic_fetch_add(p, v, __ATOMIC_RELAXED, __HIP_MEMORY_SCOPE_AGENT); }
__device__ __forceinline__ unsigned xb_xcc_id() { return (unsigned)__builtin_amdgcn_s_getreg((3 << 11) | 20) & 0xFu; }
#define XB_SPIN(cond, bar) do { unsigned _sp = 0; while (cond) { __builtin_amdgcn_s_sleep(1); \
    if ((++_sp & 255u) == 0u) { if (xb_ld(&(bar)[XB_TMO])) break; if (_sp > XB_SPIN_CAP) { atomicAdd(&(bar)[XB_TMO], 1u); break; } } } } while (0)
struct XcdBarrier { unsigned* bar; unsigned x; volatile LAS unsigned* st; int wave; };
__device__ __forceinline__ XcdBarrier xcd_barrier_post(unsigned* bar, volatile LAS unsigned* st) {
    XcdBarrier b; b.bar = bar; b.x = xb_xcc_id(); b.st = st; b.wave = 0;
    if (threadIdx.x == 0) (void)xb_add(&bar[XB_XCNT(b.x)], 1u);
    return b;
}
__device__ __forceinline__ void xcd_barrier_complete(unsigned* bar, unsigned x, unsigned& nloc, unsigned& nx) {
    const unsigned G = gridDim.x * gridDim.y * gridDim.z;
    unsigned sum, cnt, mine, sp = 0u;
    for (;;) {
        sum = 0u; cnt = 0u; mine = 0u;
#pragma unroll
        for (unsigned j = 0; j < 16; ++j) { const unsigned c = xb_ld(&bar[XB_XCNT(j)]); sum += c; cnt += (c > 0u) ? 1u : 0u; }
        mine = xb_ld(&bar[XB_XCNT(x)]);
        if (sum == G) break;
        __builtin_amdgcn_s_sleep(1);
        if ((++sp & 255u) == 0u) { if (xb_ld(&bar[XB_TMO])) break; if (sp > XB_SPIN_CAP) { atomicAdd(&bar[XB_TMO], 1u); break; } }
    }
    nloc = mine > 0u ? mine : 1u; nx = cnt > 0u ? cnt : 1u;
}
__device__ __forceinline__ void xcd_barrier(const XcdBarrier& b) {
    asm volatile("s_waitcnt vmcnt(0)" ::: "memory");
    __syncthreads();
    if (b.wave == 0 && lane_id() == 0) {
        unsigned* bar = b.bar; asm volatile("" : "+s"(bar));
        __builtin_amdgcn_s_waitcnt(0);
        unsigned nloc = b.st[0], nx = b.st[1];
        if (nloc == 0u) { xcd_barrier_complete(bar, b.x, nloc, nx); b.st[0] = nloc; b.st[1] = nx; }
        const unsigned old = xb_add(&bar[XB_XSUB(b.x)], 1u);
        const unsigned gen = old / nloc;
        if (old + 1u == (gen + 1u) * nloc) {
            __builtin_amdgcn_fence(__ATOMIC_RELEASE, "agent");
            asm volatile("s_waitcnt vmcnt(0)" ::: "memory");
            const unsigned og = xb_add(&bar[XB_TOP], 1u);
            const unsigned tg = og / nx;
            if (og + 1u == (tg + 1u) * nx) xb_add(&bar[XB_TOPGEN], 1u);
            else XB_SPIN(xb_ld(&bar[XB_TOPGEN]) == tg, bar);
            __builtin_amdgcn_fence(__ATOMIC_ACQUIRE, "agent");
            xb_add(&bar[XB_XGEN(b.x)], 1u);
            asm volatile("s_waitcnt vmcnt(0)" ::: "memory");
        } else {
            XB_SPIN(xb_ld(&bar[XB_XGEN(b.x)]) == gen, bar);
            __builtin_amdgcn_fence(__ATOMIC_ACQUIRE, "agent");
            asm volatile("s_waitcnt vmcnt(0)" ::: "memory");
        }
    }
    __syncthreads();
}

struct Args { const float* in[18]; float* out; unsigned char* ws; int ph_lo, ph_hi; };
extern __shared__ __attribute__((aligned(16))) unsigned char lds_raw[];
typedef const __attribute__((address_space(4))) Args* kargs_t;
#define KA() ({ kargs_t _p = (kargs_t)__builtin_amdgcn_kernarg_segment_ptr(); asm volatile("" : "+s"(_p)); _p; })
#define WSP(T, off) ((T*)(ka->ws + (off)))
#define INF(k) (ka->in[k])

template <int MAP> __device__ __forceinline__ int wrow_map(int n);
namespace pg8 {
constexpr int BM = 256, BK = 64, HALF = 128, HTB = HALF * BK * 2, STAGE_BYTES = 8 * HTB, NXCD = 8, WGM = 8, KK = 1024;
__host__ __device__ __forceinline__ int lds_byte(int r, int c) { const int st = (r >> 4) * 2 + (c >> 5), rr = r & 15, cc = c & 31, ob = rr * 64 + cc * 2; return st * 1024 + (ob ^ (((ob >> 9) & 1) << 5)); }
__host__ __device__ __forceinline__ void stage_rc(int b, int& R, int& C) { const int st = b / 1024, sb = b % 1024, swz = sb ^ (((sb >> 9) & 1) << 5); R = (st >> 1) * 16 + swz / 64; C = (st & 1) * 32 + (swz % 64) / 2; }
__host__ __device__ __forceinline__ int perm32(int rho) { const int n = rho >> 4, i = rho & 15; return 8 * (i >> 2) + 4 * n + (i & 3); }

struct Unit { int pm, pn, e, nvalid, mt; const char* A; const char* B; };

template <int PITCH_>
struct StaticOrderT {
    static constexpr int PITCH = PITCH_;
    int nM, nN, nwg, G, c; const char* A; const char* Bt; unsigned long long pnmap;
    __device__ void init(const void* A_, const void* Bt_, int M, int N, int G_, int c_) { A = (const char*)A_; Bt = (const char*)Bt_; nM = M / BM; nN = N / BM; nwg = nM * nN; G = G_; c = c_; pnmap = 0xFEDCBA9876543210ull; }
    __device__ void restrict_cols(unsigned long long map, int count) { pnmap = map; nN = count; nwg = nM * nN; }
    __device__ bool next(int i, Unit& u) const {
        const long L = (long)i * G + c; if (L >= nwg) return false;
        int wgid = (int)L; { const int q = nwg / NXCD, r = nwg % NXCD, xcd = wgid % NXCD, off = wgid / NXCD; wgid = (xcd < r ? xcd * (q + 1) : r * (q + 1) + (xcd - r) * q) + off; }
        const int nig = WGM * nN, gid = wgid / nig, fm = gid * WGM, gsz = (nM - fm) < WGM ? (nM - fm) : WGM;
        u.pm = fm + ((wgid % nig) % gsz); u.pn = (int)((pnmap >> (4 * ((wgid % nig) / gsz))) & 15ull); u.e = 0; u.nvalid = 256; u.mt = 0;
        u.A = A + (size_t)u.pm * (BM * PITCH); u.B = Bt + (size_t)u.pn * (BM * PITCH); return true;
    }
    __device__ __forceinline__ unsigned row_off(const Unit&, int row) const { return (unsigned)row * PITCH; }
    __device__ __forceinline__ void row_off4(const Unit&, const int (&row)[4], unsigned (&off)[4]) const {
#pragma unroll
        for (int q = 0; q < 4; ++q) off[q] = (unsigned)row[q] * PITCH; }
    __device__ __forceinline__ void list_dma(LAS unsigned char*, const Unit&, int) const {}
    __device__ __forceinline__ void row_off4_lds(LAS unsigned char*, const Unit& u, const int (&row)[4], unsigned (&off)[4]) const { row_off4(u, row, off); }
};
typedef StaticOrderT<2 * KK> StaticOrder;

template <int NTL, bool GATHER>
struct MoeOrder {
    static constexpr int PITCH = MOE_FP8 ? KK : 2 * KK;
    int MT, G, c, L; const LAS int* pre;
    __device__ bool next(int i, Unit& u) const {
        const long Lu = (long)i * G + c; int M, nt;
        if (G == 256) { const int win = (int)(Lu >> 8), w = (int)(Lu & 255), x = w & 7, j = w >> 3;
            if (NTL == 8) { M = 32 * win + 4 * x + (j >> 3); nt = j & 7; } else { M = 64 * win + 8 * x + (j >> 2); nt = j & 3; } }
        else { M = (int)(Lu / NTL); nt = (int)(Lu % NTL); }
        if (M >= MT) return false;
        const LAS int* pp = pre; asm volatile("" : "+v"(pp));
        const int e = __builtin_amdgcn_readfirstlane(pp[(MO_T2E - MO_PRE) / 4 + M]);
        const int mt = M - __builtin_amdgcn_readfirstlane(pp[e]);
        u.pm = M; u.pn = nt; u.e = e; u.mt = mt; const int left = __builtin_amdgcn_readfirstlane(pp[(MO_CNT - MO_PRE) / 4 + e]) - 256 * mt; u.nvalid = left < 256 ? left : 256;
        kargs_t ka = KA();
        const char* W = (const char*)ka->ws + (NTL == 8 ? WS_WGU : WS_WDN) + ((size_t)L * NE + e) * ((size_t)(NTL == 8 ? 2048 : 1024) * PITCH);
        u.B = W + (size_t)nt * (BM * PITCH);
        u.A = GATHER ? (const char*)ka->ws + WS_H8 : (const char*)ka->ws + WS_ACT + (size_t)M * (BM * PITCH);
        return true;
    }
    __device__ __forceinline__ unsigned row_off(const Unit& u, int row) const {
        if (!GATHER) return (unsigned)row * PITCH;
        const int rr = row < u.nvalid ? row : 0;
        kargs_t ka = KA(); const int* list = (const int*)(ka->ws + WS_LIST);
        const int ent = list[(size_t)u.e * NTOK + (size_t)u.mt * 256 + rr];
        return (unsigned)(ent >> 2) * PITCH;
    }
    __device__ __forceinline__ void list_dma(LAS unsigned char* lds, const Unit& u, int wid) const {
        if (!GATHER) return;
        if (wid == 0) { kargs_t ka = KA(); const int* lp = (const int*)(ka->ws + WS_LIST) + (size_t)u.e * NTOK + (size_t)u.mt * 256 + 4 * lane_id();
            __builtin_amdgcn_global_load_lds((const unsigned*)lp, (LAS unsigned*)(lds + MISC_OFF + MO_RF), 16, 0, 0); }
    }
    __device__ __forceinline__ void row_off4_lds(LAS unsigned char* lds, const Unit& u, const int (&row)[4], unsigned (&off)[4]) const {
        const LAS int* ll = (const LAS int*)(lds + MISC_OFF + MO_RF);
        int ent[4];
#pragma unroll
        for (int q = 0; q < 4; ++q) ent[q] = GATHER ? ll[row[q] < u.nvalid ? row[q] : 0] : 0;
#pragma unroll
        for (int q = 0; q < 4; ++q) off[q] = GATHER ? (unsigned)(ent[q] >> 2) * PITCH : (unsigned)row[q] * PITCH;
    }
    __device__ __forceinline__ void row_off4(const Unit& u, const int (&row)[4], unsigned (&off)[4]) const {
        if (!GATHER) {
#pragma unroll
            for (int q = 0; q < 4; ++q) off[q] = (unsigned)row[q] * PITCH;
            return; }
        kargs_t ka = KA(); const int* lp = (const int*)(ka->ws + WS_LIST) + (size_t)u.e * NTOK + (size_t)u.mt * 256;
        int ent[4];
#pragma unroll
        for (int q = 0; q < 4; ++q) ent[q] = lp[row[q] < u.nvalid ? row[q] : 0];
#pragma unroll
        for (int q = 0; q < 4; ++q) off[q] = (unsigned)(ent[q] >> 2) * PITCH;
    }
};

__device__ __forceinline__ unsigned cvt_pk_bf16(float lo, float hi) { return pk2(lo, hi); }

template <class Epi, class Sched, bool DYN_A, bool FP8 = false>
__device__ __forceinline__ void gemm_phase(LAS unsigned char* lds, const int wid, const Sched& S, const Epi& E, const bool dry = false) {
    const int lane = lane_id(), tid = 64 * wid + lane, wr = wid >> 2, wc = wid & 3, fr = lane & 15, fq = lane >> 4;
    constexpr int PITCH = Sched::PITCH, nt = PITCH / 128;
    static_assert(PITCH == (FP8 ? KK : 2 * KK), "operand pitch vs element type");
    unsigned voffB[2];
#pragma unroll
    for (int i = 0; i < 2; ++i) { int R, C; stage_rc(tid * 16 + i * 8192, R, C); const int Rb = Epi::PERM ? ((R & ~31) + perm32(R & 31)) : R; voffB[i] = (unsigned)(Rb * PITCH + C * 2); }
    const size_t kstep = (size_t)(BK * 2);
    const size_t hstep = (size_t)HALF * PITCH;
    const unsigned ldsw = (unsigned)wid * 1024u;
    const int aoff = lds_byte(wr * 64 + fr, fq * 8), boff = lds_byte(wc * 32 + fr, fq * 8);
#define PG8_SA(b, h) (((b) * 2 + (h)) * HTB)
#define PG8_SB(b, h) ((4 + (b) * 2 + (h)) * HTB)
#define PG8_STAGE(bufoff, gbase, voff) do { _Pragma("unroll") for (int _i = 0; _i < 2; ++_i) { unsigned o_ = (voff)[_i]; asm volatile("" : "+v"(o_));     \
        __builtin_amdgcn_global_load_lds((const unsigned*)((const char*)(gbase) + o_), (LAS unsigned*)(lds + (bufoff) + ldsw + _i * 8192), 16, 0, 0); } } while (0)
#define PG8_LDA(dst, b, h) do { _Pragma("unroll") for (int m = 0; m < 4; ++m) _Pragma("unroll") for (int k = 0; k < 2; ++k) dst[m][k] = *(const LAS bf16x8*)(lds + PG8_SA(b, h) + aoff + m * 2048 + k * 1024); } while (0)
#define PG8_LDB(dst, b, h) do { _Pragma("unroll") for (int n = 0; n < 2; ++n) _Pragma("unroll") for (int k = 0; k < 2; ++k) dst[n][k] = *(const LAS bf16x8*)(lds + PG8_SB(b, h) + boff + n * 2048 + k * 1024); } while (0)
#define PG8_AOFF_L(dst, u) do { const int t_ = 64 * wid + lane_id(); int R0_, C0_, R1_, C1_; stage_rc(t_ * 16, R0_, C0_); stage_rc(t_ * 16 + 8192, R1_, C1_); \
        const int rows_[4] = {R0_, R1_, HALF + R0_, HALF + R1_}; unsigned off_[4]; S.row_off4_lds(lds, u, rows_, off_); \
        dst[0][0] = off_[0] + (unsigned)C0_ * 2u; dst[0][1] = off_[1] + (unsigned)C1_ * 2u; dst[1][0] = off_[2] + (unsigned)C0_ * 2u; dst[1][1] = off_[3] + (unsigned)C1_ * 2u; } while (0)
#define PG8_CAT(x0, x1) __builtin_bit_cast(v8i32, __builtin_shufflevector(x0, x1, 0, 1, 2, 3, 4, 5, 6, 7, 8, 9, 10, 11, 12, 13, 14, 15))
#define PG8_MMA(ai, bj, At, Bt) do { __builtin_amdgcn_s_setprio(1); _Pragma("unroll") for (int m = 0; m < 4; ++m) _Pragma("unroll") for (int n = 0; n < 2; ++n) { \
        if (FP8) acc[ai][bj][m][n] = __builtin_amdgcn_mfma_scale_f32_16x16x128_f8f6f4(PG8_CAT(Bt[n][0], Bt[n][1]), PG8_CAT(At[m][0], At[m][1]), acc[ai][bj][m][n], 0, 0, 0, sc1_, 0, sc1_); \
        else { _Pragma("unroll") for (int k = 0; k < 2; ++k) acc[ai][bj][m][n] = __builtin_amdgcn_mfma_f32_16x16x32_bf16(Bt[n][k], At[m][k], acc[ai][bj][m][n], 0, 0, 0); } } \
        __builtin_amdgcn_s_setprio(0); } while (0)
#define PG8_WAIT_V(n) asm volatile("s_waitcnt vmcnt(" #n ")" ::: "memory")
#define PG8_WAIT_L(n) asm volatile("s_waitcnt lgkmcnt(" #n ")" ::: "memory")
#define PG8_BAR __builtin_amdgcn_s_barrier()
#define PG8_SCHED __builtin_amdgcn_sched_barrier(0)
#define PG8_AOFF(dst, u) do { const int t_ = 64 * wid + lane_id(); int R0_, C0_, R1_, C1_; stage_rc(t_ * 16, R0_, C0_); stage_rc(t_ * 16 + 8192, R1_, C1_); \
        const int rows_[4] = {R0_, R1_, HALF + R0_, HALF + R1_}; unsigned off_[4]; S.row_off4(u, rows_, off_); \
        dst[0][0] = off_[0] + (unsigned)C0_ * 2u; dst[0][1] = off_[1] + (unsigned)C1_ * 2u; dst[1][0] = off_[2] + (unsigned)C0_ * 2u; dst[1][1] = off_[3] + (unsigned)C1_ * 2u; } while (0)
    int sc1_ = 0x7f7f7f7f; asm volatile("" : "+v"(sc1_));
    Unit cur, nxt; int ui = 0;
    if (!S.next(0, cur)) return;
    f32x4 acc[2][2][4][2];
#pragma unroll
    for (int a = 0; a < 2; ++a)
#pragma unroll
        for (int b = 0; b < 2; ++b)
#pragma unroll
            for (int m = 0; m < 4; ++m)
#pragma unroll
                for (int n = 0; n < 2; ++n) acc[a][b][m][n] = (f32x4){0.f, 0.f, 0.f, 0.f};
    bf16x8 At[4][2], B0[2][2], B1[2][2];
    unsigned vA[2][2], vA2[2][2];
    PG8_AOFF(vA, cur);
#pragma unroll
    for (int h = 0; h < 2; ++h)
#pragma unroll
        for (int i = 0; i < 2; ++i) vA2[h][i] = vA[h][i];
    const char* cA = cur.A; const char* cB = cur.B;
    PG8_STAGE(PG8_SB(0, 0), cB, voffB); PG8_STAGE(PG8_SB(0, 1), cB + hstep, voffB); PG8_STAGE(PG8_SA(0, 0), cA, vA[0]); PG8_STAGE(PG8_SA(0, 1), cA, vA[1]);
    if (wr == 1) PG8_BAR;
    PG8_WAIT_V(2); PG8_BAR;
    PG8_STAGE(PG8_SB(1, 0), cB + kstep, voffB); PG8_STAGE(PG8_SA(1, 0), cA + kstep, vA[0]); PG8_STAGE(PG8_SB(1, 1), cB + hstep + kstep, voffB);
    PG8_WAIT_V(6); PG8_BAR;
    for (;;) {
        if constexpr (Epi::KHOOK) E.prep(cur, ui & 1, tid, lds);
        const bool has_next = S.next(ui + 1, nxt);
        const char* nA = has_next ? nxt.A : cA; const char* nB = has_next ? nxt.B : cB;
        if constexpr (Epi::BIAS_LDS) E.bias_dma(lds, cur, ui & 1, wid);
        if (DYN_A) { if (has_next) S.list_dma(lds, nxt, wid); }
#pragma unroll 1
        for (int t = 0; t < nt; t += 2) {
            const bool last = (t == nt - 2);
            const char* a1 = cA + (size_t)(t + 1) * kstep;
            const char* a2 = last ? nA : cA + (size_t)(t + 2) * kstep; const char* b2 = last ? nB : cB + (size_t)(t + 2) * kstep;
            const char* a3 = a2 + kstep; const char* b3 = b2 + kstep;
            if (DYN_A) { if (last && has_next) { PG8_AOFF_L(vA2, nxt); } }
            if constexpr (Epi::KHOOK) { if (t == 4 || t == 10) E.khook(acc, cur, t, wr, lane_id(), ui & 1, lds); }
            PG8_LDB(B0, 0, 0); PG8_LDB(B1, 0, 1); PG8_SCHED; PG8_LDA(At, 0, 0); PG8_STAGE(PG8_SA(1, 1), a1, vA[1]);
            PG8_WAIT_V(8); PG8_WAIT_L(0); PG8_BAR; PG8_MMA(0, 0, At, B0); PG8_MMA(0, 1, At, B1); PG8_BAR; PG8_SCHED;
            PG8_LDA(At, 0, 1); PG8_STAGE(PG8_SB(0, 0), b2, voffB); PG8_STAGE(PG8_SB(0, 1), b2 + hstep, voffB); PG8_STAGE(PG8_SA(0, 0), a2, vA2[0]);
            PG8_WAIT_V(8); PG8_WAIT_L(0); PG8_BAR; PG8_MMA(1, 0, At, B0); PG8_MMA(1, 1, At, B1); PG8_BAR; PG8_SCHED;
            PG8_LDB(B0, 1, 0); PG8_LDB(B1, 1, 1); PG8_SCHED; PG8_LDA(At, 1, 0); PG8_STAGE(PG8_SA(0, 1), a2, vA2[1]);
            PG8_WAIT_V(8); PG8_WAIT_L(0); PG8_BAR; PG8_MMA(0, 0, At, B0); PG8_MMA(0, 1, At, B1); PG8_BAR; PG8_SCHED;
            PG8_LDA(At, 1, 1); PG8_STAGE(PG8_SB(1, 0), b3, voffB); PG8_STAGE(PG8_SB(1, 1), b3 + hstep, voffB); PG8_STAGE(PG8_SA(1, 0), a3, vA2[0]);
            PG8_WAIT_V(8); PG8_WAIT_L(0); PG8_BAR; PG8_MMA(1, 0, At, B0); PG8_MMA(1, 1, At, B1); PG8_BAR; PG8_SCHED;
        }
        if (wr == 0) PG8_BAR;
        if constexpr (Epi::KHOOK) { if (!dry) E.fin(acc, cur, wr, wc, lane_id(), ui & 1, lds); }
        else if (!dry) { if constexpr (Epi::BIAS_LDS) E(acc, cur, wr, wc, lane_id(), ui, lds); else E(acc, cur, wr, wc, lane_id()); }
        else { float sink = 0.f;
#pragma unroll
            for (int a = 0; a < 2; ++a)
#pragma unroll
                for (int b = 0; b < 2; ++b)
#pragma unroll
                    for (int m = 0; m < 4; ++m)
#pragma unroll
                        for (int n = 0; n < 2; ++n) sink += acc[a][b][m][n][0] + acc[a][b][m][n][1] + acc[a][b][m][n][2] + acc[a][b][m][n][3];
            asm volatile("" :: "v"(sink)); }
        if (!has_next) break;
#pragma unroll
        for (int a = 0; a < 2; ++a)
#pragma unroll
            for (int b = 0; b < 2; ++b)
#pragma unroll
                for (int m = 0; m < 4; ++m)
#pragma unroll
                    for (int n = 0; n < 2; ++n) acc[a][b][m][n] = (f32x4){0.f, 0.f, 0.f, 0.f};
        cur = nxt; cA = nA; cB = nB; ++ui;
#pragma unroll
        for (int h = 0; h < 2; ++h)
#pragma unroll
            for (int i = 0; i < 2; ++i) vA[h][i] = vA2[h][i];
        if (wr == 1) PG8_BAR;
    }
    PG8_WAIT_V(0);
    PG8_BAR;
#undef PG8_SA
#undef PG8_SB
#undef PG8_STAGE
#undef PG8_LDA
#undef PG8_LDB
#undef PG8_MMA
#undef PG8_WAIT_V
#undef PG8_WAIT_L
#undef PG8_BAR
#undef PG8_SCHED
#undef PG8_AOFF
#undef PG8_AOFF_L
#undef PG8_CAT
}

struct EpiQKV {
    static constexpr bool PERM = true, KHOOK = false, BIAS_LDS = false;
    bf16_t* Qo; const float* rope; float wsc;
    __device__ __forceinline__ void operator()(const f32x4 (&acc)[2][2][4][2], const Unit& u, int wr, int wc, int ln_) const {
        const int fr = ln_ & 15, fq = (ln_ >> 4) & 3;
        const int region = u.pn >> 2, tcol = (u.pn & 3) * 256;
        bf16_t* base = Qo + (size_t)region * ((WS_K - WS_Q) / 2);
        const float sc = (region == 0 ? QSCALE : 1.0f) * wsc;
#pragma unroll
        for (int bj = 0; bj < 2; ++bj) {
            const int cg = tcol + 128 * bj + 32 * wc, head = cg >> 6;
            const bool rope_on = (region < 2) && (head >= 4) && (head < 10);
            if (!rope_on) {
#pragma unroll
                for (int ai = 0; ai < 2; ++ai)
#pragma unroll
                    for (int m = 0; m < 4; ++m) { const size_t row = (size_t)u.pm * BM + ai * HALF + wr * 64 + m * 16 + fr;
                        const f32x4 v0 = acc[ai][bj][m][0] * sc, v1 = acc[ai][bj][m][1] * sc; u32x4 w;
                        w.x = pk2(v0[0], v0[1]); w.y = pk2(v0[2], v0[3]); w.z = pk2(v1[0], v1[1]); w.w = pk2(v1[2], v1[3]);
                        *(u32x4*)(base + row * DM + cg + 8 * fq) = w; }
            } else {
                const int j0 = 16 * ((cg >> 5) & 1) + 4 * fq;
#pragma unroll
                for (int ai = 0; ai < 2; ++ai)
#pragma unroll
                    for (int m = 0; m < 4; ++m) { const size_t row = (size_t)u.pm * BM + ai * HALF + wr * 64 + m * 16 + fr;
                        const f32x4 v0 = acc[ai][bj][m][0] * sc, v1 = acc[ai][bj][m][1] * sc;
                        const f32x4 cs0 = *(const f32x4*)(rope + row * 64 + 2 * j0), cs1 = *(const f32x4*)(rope + row * 64 + 2 * j0 + 4);
                        const float a0 = v0[0] * cs0[0] - v0[1] * cs0[1], b0 = v0[1] * cs0[0] + v0[0] * cs0[1];
                        const float a1 = v0[2] * cs0[2] - v0[3] * cs0[3], b1 = v0[3] * cs0[2] + v0[2] * cs0[3];
                        const float a2 = v1[0] * cs1[0] - v1[1] * cs1[1], b2 = v1[1] * cs1[0] + v1[0] * cs1[1];
                        const float a3 = v1[2] * cs1[2] - v1[3] * cs1[3], b3 = v1[3] * cs1[2] + v1[2] * cs1[3];
                        u32x2 wa, wb; wa.x = pk2(a0, a1); wa.y = pk2(a2, a3); wb.x = pk2(b0, b1); wb.y = pk2(b2, b3);
                        bf16_t* rp = base + row * DM + head * 64 + j0;
                        *(u32x2*)rp = wa; *(u32x2*)(rp + 32) = wb; }
            }
        }
    }
};
struct EpiOut {
    static constexpr bool PERM = true, KHOOK = (FUSE_ONORM != 0), BIAS_LDS = false;
    const float* base32; const bf16_t* base16; bf16_t* out16; const float* ga; const float* ss;
    __device__ __forceinline__ void prep(const Unit& u, int par, int tid, LAS unsigned char* lds) const {
        if (tid < 256) { const f32x4* sp = (const f32x4*)(ss + 16 * ((size_t)u.pm * BM + tid)); const f32x4 a = sp[0], b = sp[1], c = sp[2], d = sp[3];
            const float s0 = (a[0] + a[1]) + (a[2] + a[3]), s1 = ((b[0] + b[1]) + (b[2] + b[3])) + (c[0] + c[1]), s2 = (c[2] + c[3]) + ((d[0] + d[1]) + (d[2] + d[3]));
            const float r0 = frsq(s0 * (1.0f / 256) + EPS), r1 = frsq(s1 * (1.0f / 384) + EPS), r2 = frsq(s2 * (1.0f / 384) + EPS);
            *(LAS f32x4*)(lds + MISC_OFF + MO_RF + par * 4096 + tid * 16) = (f32x4){r0 * frcp(r1), r1 * frcp(r2), r2, 0.f}; }
    }
    __device__ __forceinline__ void khook(f32x4 (&acc)[2][2][4][2], const Unit& u, int t, int wr, int ln_, int par, LAS unsigned char* lds) const {
        const int fr = ln_ & 15, gp = (t == 4) ? 0 : 1;
#pragma unroll
        for (int ai = 0; ai < 2; ++ai)
#pragma unroll
            for (int m = 0; m < 4; ++m) { const int r = ai * HALF + wr * 64 + m * 16 + fr; const float f = *(const LAS float*)(lds + MISC_OFF + MO_RF + par * 4096 + r * 16 + 4 * gp);
#pragma unroll
                for (int bj = 0; bj < 2; ++bj)
#pragma unroll
                    for (int n = 0; n < 2; ++n) acc[ai][bj][m][n] = acc[ai][bj][m][n] * f; }
    }
    __device__ __forceinline__ void fin(const f32x4 (&acc)[2][2][4][2], const Unit& u, int wr, int wc, int ln_, int par, LAS unsigned char* lds) const {
        const int fr = ln_ & 15, fq = (ln_ >> 4) & 3;
        const int b = (u.pm * BM) / SEQ; const float* gab = ga + (size_t)b * (NMOD * DM);
        float r2[2][4];
#pragma unroll
        for (int ai = 0; ai < 2; ++ai)
#pragma unroll
            for (int m = 0; m < 4; ++m) r2[ai][m] = FUSE_ONORM ? *(const LAS float*)(lds + MISC_OFF + MO_RF + par * 4096 + (ai * HALF + wr * 64 + m * 16 + fr) * 16 + 8) : 1.0f;
#pragma unroll
        for (int bj = 0; bj < 2; ++bj) { const int col = u.pn * BM + bj * HALF + wc * 32 + 8 * fq; const f32x4 g0 = *(const f32x4*)(gab + col), g1 = *(const f32x4*)(gab + col + 4);
#pragma unroll
            for (int ai = 0; ai < 2; ++ai)
#pragma unroll
                for (int m = 0; m < 4; ++m) { const size_t off = ((size_t)u.pm * BM + ai * HALF + wr * 64 + m * 16 + fr) * DM + col; f32x4 b0, b1;
                    if (base32) { b0 = *(const f32x4*)(base32 + off); b1 = *(const f32x4*)(base32 + off + 4); }
                    else { const u32x4 w = *(const u32x4*)(base16 + off); b0 = (f32x4){bf_lo(w.x), bf_hi(w.x), bf_lo(w.y), bf_hi(w.y)}; b1 = (f32x4){bf_lo(w.z), bf_hi(w.z), bf_lo(w.w), bf_hi(w.w)}; }
                    const f32x4 o0 = b0 + (g0 * r2[ai][m]) * acc[ai][bj][m][0], o1 = b1 + (g1 * r2[ai][m]) * acc[ai][bj][m][1];
                    u32x4 w; w.x = pk2(o0[0], o0[1]); w.y = pk2(o0[2], o0[3]); w.z = pk2(o1[0], o1[1]); w.w = pk2(o1[2], o1[3]);
                    *(u32x4*)(out16 + off) = w; } }
    }
    __device__ __forceinline__ void operator()(const f32x4 (&acc)[2][2][4][2], const Unit& u, int wr, int wc, int ln_) const { fin(acc, u, wr, wc, ln_, 0, nullptr); }
};
struct EpiGU {
    static constexpr bool PERM = true, KHOOK = false, BIAS_LDS = true;
    int L;
    __device__ __forceinline__ void bias_dma(LAS unsigned char* lds, const Unit& u, int par, int wid) const {
        if (wid == 0) { const int ln = lane_id(); kargs_t ka = KA(); const float* bgu = ka->in[14] + (size_t)L * NE * 2048;
            const float* p = bgu + (size_t)u.e * 2048 + 128 * u.pn + (ln < 32 ? 4 * ln : 1024 + 4 * (ln - 32));
            __builtin_amdgcn_global_load_lds((const unsigned*)p, (LAS unsigned*)(lds + MISC_OFF + MO_RF + 2048 + par * 1024), 16, 0, 0); }
    }
    __device__ __forceinline__ void operator()(const f32x4 (&acc)[2][2][4][2], const Unit& u, int wr, int wc, int ln_, int ui_, LAS unsigned char* lds) const {
        const int par = ui_ & 1;
        const int fr = ln_ & 15, fq = (ln_ >> 4) & 3;
        kargs_t ka = KA(); unsigned char* act = ka->ws + WS_ACT;
        int blk_ = blockIdx.x; asm volatile("" : "+s"(blk_));
        const int cvi = (ui_ * 256 + blk_) * 8 + wr * 4 + wc;
        const bool cvn_ = (L + 1 < DEPTH) && (cvi < 24576), cv0_ = (L == 0) && (ui_ >= 12) && (ui_ < 16);
        const bool cv = EPI_CONV && (cvn_ || cv0_) && (gridDim.x == 256);
        const int Lc = cvn_ ? L + 1 : 0;
        f32x4 cvv[16]; const float* cvs = nullptr; unsigned char* cvd = nullptr; int cvn = 0, cvld = 0, cvgu = 0;
        if (cv) { const int g = ln_ >> 3, cq = ln_ & 7; int r = cvn_ ? cvi : 16384 + cvi - 24576;
            if (r < 16384) { const int e = r / 512, q = r % 512, k0 = 128 * (q / 64), n0 = 32 * (q % 64); cvld = 2048; cvgu = 1; cvn = n0 + 4 * cq;
                cvs = ka->in[13] + ((size_t)Lc * NE + e) * DM * 2048 + (size_t)(k0 + 16 * g) * 2048 + n0 + 4 * cq; cvd = ka->ws + WS_WGU + ((size_t)Lc * NE + e) * 2048 * DM + k0 + 16 * g; }
            else { r -= 16384; const int e = r / 256, q = r % 256, k0 = 128 * (q / 32), n0 = 32 * (q % 32); cvld = DM; cvgu = 0; cvn = n0 + 4 * cq;
                cvs = ka->in[15] + ((size_t)Lc * NE + e) * DM * DM + (size_t)(k0 + 16 * g) * DM + n0 + 4 * cq; cvd = ka->ws + WS_WDN + ((size_t)Lc * NE + e) * DM * DM + k0 + 16 * g; }
#pragma unroll
            for (int i = 0; i < 16; ++i) cvv[i] = *(const f32x4u*)(cvs + (size_t)i * cvld);
        } else {
#pragma unroll
            for (int i = 0; i < 16; ++i) cvv[i] = (f32x4){0.f, 0.f, 0.f, 0.f};
        }
        const int jl = 128 * u.pn + 32 * wc + 8 * fq; const LAS float* bb = (const LAS float*)(lds + MISC_OFF + MO_RF + 2048 + par * 1024) + 32 * wc + 8 * fq;
        const f32x4 bg0 = *(const LAS f32x4*)(bb), bg1 = *(const LAS f32x4*)(bb + 4), bu0 = *(const LAS f32x4*)(bb + 128), bu1 = *(const LAS f32x4*)(bb + 132);
#pragma unroll
        for (int ai = 0; ai < 2; ++ai)
#pragma unroll
            for (int m = 0; m < 4; ++m) { const size_t row = (size_t)u.pm * BM + ai * HALF + wr * 64 + m * 16 + fr;
                float o[8];
#pragma unroll
                for (int n = 0; n < 2; ++n) { const float ws_ = MOE_FP8 ? (1.0f / 32.0f) : 1.0f; const f32x4 gv = acc[ai][0][m][n] * ws_ + (n ? bg1 : bg0), uv = acc[ai][1][m][n] * ws_ + (n ? bu1 : bu0);
#pragma unroll
                    for (int i = 0; i < 4; ++i) { const float g = fminf(gv[i], 7.0f), up = fminf(fmaxf(uv[i], -7.0f), 7.0f);
                        const float sg = frcp(1.0f + fexp2(-1.702f * LOG2E * g)); o[4 * n + i] = (up + 1.0f) * (g * sg); } }
                if (MOE_FP8) { u32x2 w; w.x = pk4_fp8(o[0], o[1], o[2], o[3]); w.y = pk4_fp8(o[4], o[5], o[6], o[7]); *(u32x2*)(act + row * DM + jl) = w; }
                else { u32x4 w; w.x = pk2(o[0], o[1]); w.y = pk2(o[2], o[3]); w.z = pk2(o[4], o[5]); w.w = pk2(o[6], o[7]); *(u32x4*)((bf16_t*)act + row * DM + jl) = w; } }
        if (cv) {
#pragma unroll
            for (int c = 0; c < 4; ++c) { const int n_ = cvn + c; const int prow = cvgu ? ::wrow_map<2>(n_) : ::wrow_map<3>(n_); u32x4 a;
                a.x = pk4_fp8(cvv[0][c] * 32.0f, cvv[1][c] * 32.0f, cvv[2][c] * 32.0f, cvv[3][c] * 32.0f); a.y = pk4_fp8(cvv[4][c] * 32.0f, cvv[5][c] * 32.0f, cvv[6][c] * 32.0f, cvv[7][c] * 32.0f);
                a.z = pk4_fp8(cvv[8][c] * 32.0f, cvv[9][c] * 32.0f, cvv[10][c] * 32.0f, cvv[11][c] * 32.0f); a.w = pk4_fp8(cvv[12][c] * 32.0f, cvv[13][c] * 32.0f, cvv[14][c] * 32.0f, cvv[15][c] * 32.0f);
                *(u32x4*)(cvd + (size_t)prow * DM) = a; }
        }
    }
};
struct EpiDN {
    static constexpr bool PERM = true, KHOOK = false, BIAS_LDS = true;
    int L;
    __device__ __forceinline__ void bias_dma(LAS unsigned char* lds, const Unit& u, int par, int wid) const {
        if (wid == 0) { kargs_t ka = KA(); const float* p = ka->in[16] + (size_t)L * NE * DM + (size_t)u.e * DM + u.pn * BM + 4 * lane_id();
            __builtin_amdgcn_global_load_lds((const unsigned*)p, (LAS unsigned*)(lds + MISC_OFF + MO_RF + 2048 + par * 1024), 16, 0, 0); }
    }
    __device__ __forceinline__ void operator()(const f32x4 (&acc)[2][2][4][2], const Unit& u, int wr, int wc, int ln_, int ui_, LAS unsigned char* lds) const {
        const int par = ui_ & 1;
        const int fr = ln_ & 15, fq = (ln_ >> 4) & 3;
        kargs_t ka = KA(); bf16_t* outb = (bf16_t*)(ka->ws + WS_OUTB); const float* bdn = ka->in[16] + (size_t)L * NE * DM; const int* list = (const int*)(ka->ws + WS_LIST); const float* topg = (const float*)(ka->ws + WS_TOPG);
        const int* lp = list + (size_t)u.e * NTOK + (size_t)u.mt * 256;
        f32x4 bv[2][2];
#pragma unroll
        for (int bj = 0; bj < 2; ++bj)
#pragma unroll
            for (int n = 0; n < 2; ++n) bv[bj][n] = *(const LAS f32x4*)((const LAS float*)(lds + MISC_OFF + MO_RF + 2048 + par * 1024) + 64 * wc + 16 * fq + 8 * bj + 4 * n);
        if (SLOT_OUT && OUT_FP8) {
            unsigned char* ob = (unsigned char*)outb;
#pragma unroll
            for (int ai = 0; ai < 2; ++ai)
#pragma unroll
                for (int m = 0; m < 4; ++m) { const size_t row = (size_t)u.pm * BM + ai * HALF + wr * 64 + m * 16 + fr; u32x4 w16;
#pragma unroll
                    for (int bj = 0; bj < 2; ++bj) { const float ws_ = MOE_FP8 ? (1.0f / 32.0f) : 1.0f;
                        const f32x4 q0 = (acc[ai][bj][m][0] * ws_ + bv[bj][0]) * 16.0f, q1 = (acc[ai][bj][m][1] * ws_ + bv[bj][1]) * 16.0f; f32x4 c0, c1;
#pragma unroll
                        for (int i = 0; i < 4; ++i) { c0[i] = fminf(fmaxf(q0[i], -448.0f), 448.0f); c1[i] = fminf(fmaxf(q1[i], -448.0f), 448.0f); }
                        const unsigned lo = pk4_fp8(c0[0], c0[1], c0[2], c0[3]), hi = pk4_fp8(c1[0], c1[1], c1[2], c1[3]);
                        if (bj == 0) { w16.x = lo; w16.y = hi; } else { w16.z = lo; w16.w = hi; } }
                    *(u32x4*)(ob + row * DM + u.pn * BM + 64 * wc + 16 * fq) = w16; }
            return; }
        static_assert(SLOT_OUT && OUT_FP8 && MOE_FP8, "the other output paths assume the unpermuted w_dn row order");
#pragma unroll
        for (int ai = 0; ai < 2; ++ai)
#pragma unroll
            for (int m = 0; m < 4; ++m) { const int r = ai * HALF + wr * 64 + m * 16 + fr;
                if (r < u.nvalid) { const int ent = lp[r]; const float gw = topg[ent]; bf16_t* rp = outb + (size_t)ent * DM + u.pn * BM + wc * 32 + 8 * fq;
#pragma unroll
                    for (int bj = 0; bj < 2; ++bj) { const float ws_ = MOE_FP8 ? (1.0f / 32.0f) : 1.0f;
                        if (OUT_FP8) { const f32x4 q0 = (acc[ai][bj][m][0] * ws_ + bv[bj][0]) * (gw * 16.0f), q1 = (acc[ai][bj][m][1] * ws_ + bv[bj][1]) * (gw * 16.0f);
                            f32x4 c0, c1;
#pragma unroll
                            for (int i = 0; i < 4; ++i) { c0[i] = fminf(fmaxf(q0[i], -448.0f), 448.0f); c1[i] = fminf(fmaxf(q1[i], -448.0f), 448.0f); }
                            u32x2 w8; w8.x = pk4_fp8(c0[0], c0[1], c0[2], c0[3]); w8.y = pk4_fp8(c1[0], c1[1], c1[2], c1[3]);
                            *(u32x2*)((unsigned char*)outb + (size_t)ent * DM + u.pn * BM + wc * 32 + 8 * fq + bj * HALF) = w8; continue; } const f32x4 v0 = (acc[ai][bj][m][0] * ws_ + bv[bj][0]) * gw, v1 = (acc[ai][bj][m][1] * ws_ + bv[bj][1]) * gw; u32x4 w;
                        w.x = pk2(v0[0], v0[1]); w.y = pk2(v0[2], v0[3]); w.z = pk2(v1[0], v1[1]); w.w = pk2(v1[2], v1[3]);
                        *(u32x4*)(rp + bj * HALF) = w; } } }
    }
};
}

namespace att {
constexpr int OFF_K = 0, OFF_V = 32768, OFF_BIAS = 65536;
__device__ __forceinline__ int crow(int r, int hi) { return (r & 3) + 8 * (r >> 2) + 4 * hi; }
__device__ __forceinline__ float max3f(float a, float b, float c) { float r; asm("v_max3_f32 %0, %1, %2, %3" : "=v"(r) : "v"(a), "v"(b), "v"(c)); return r; }

template <int TYPE>
__device__ __forceinline__ void attn_unit(LAS unsigned char* lds, volatile LAS int* misc, const bf16_t* __restrict__ Q, const bf16_t* __restrict__ Kg, const bf16_t* __restrict__ Vg, bf16_t* __restrict__ O,
                                          const float* __restrict__ lf2, float* __restrict__ ssrow, int b, int head, int qb, const int tid, gu32* qhead) {
    const int wid = __builtin_amdgcn_readfirstlane(tid >> 6), lane = tid & 63, r32 = lane & 31, hh = lane >> 5;
    const int tq = 256 * qb + 32 * wid + r32;
    const size_t grow = (size_t)b * SEQ + tq;
    const int qlo = 256 * qb + 32 * wid, qhi = qlo + 31;
    LAS float* bias = (LAS float*)(lds + OFF_BIAS);
    if (TYPE == 2) {
        const int n = 256 * (qb + 1), i4 = tid * 4;
        f32x4 v = (f32x4){0.f, 0.f, 0.f, 0.f};
        if (i4 < n) v = *(const f32x4*)(lf2 + i4);
        v[1] += v[0]; v[2] += v[1]; v[3] += v[2];
        float tot = v[3], inc = tot;
#pragma unroll
        for (int o = 1; o < 64; o <<= 1) { const float t = __builtin_bit_cast(float, __builtin_amdgcn_ds_bpermute((lane - o) << 2, __builtin_bit_cast(int, inc))); if (lane >= o) inc += t; }
        LAS float* sc = (LAS float*)(misc + (MO_SCAN / 4));
        if (lane == 63) sc[wid] = inc;
        __syncthreads();
        float woff = 0.f;
#pragma unroll
        for (int w = 0; w < 8; ++w) woff += (w < wid) ? sc[w] : 0.f;
        const float ex = woff + inc - tot;
        *(LAS f32x4*)(bias + i4) = (f32x4){ex + v[0], ex + v[1], ex + v[2], ex + v[3]};
        __syncthreads();
        const float cref = bias[n - 1];
        __syncthreads();
        f32x4 c4 = *(LAS f32x4*)(bias + i4); c4 = cref - c4; *(LAS f32x4*)(bias + i4) = c4;
    }
    bf16x8 qf[4];
#pragma unroll
    for (int s = 0; s < 4; ++s) qf[s] = *(const bf16x8*)(Q + grow * DM + head * 64 + 16 * s + 8 * hh);
    float lbn[16];
    if (TYPE == 1) {
#pragma unroll
        for (int r = 0; r < 16; ++r) { const int c = (tq - crow(r, hh)) & 15; const bool m16 = (c == 0), m4 = ((c & 3) == 0);
            lbn[r] = m16 ? 1.5849625007211562f : (m4 ? 1.0f : 0.0f); }
    }
#define LB_MID(v) ((v) > 1.25f ? 1.0f : ((v) > 0.5f ? 0.0f : -INFINITY))
#define LB_FAR(v) ((v) > 1.25f ? 0.0f : -INFINITY)
    const int skv = tid >> 3, sch = tid & 7;
    const unsigned kst = 128u * skv + ((unsigned)(sch ^ ((skv >> 1) & 7)) << 4);
    const unsigned vst = 128u * skv + (((unsigned)sch << 4) ^ (((unsigned)(skv >> 1) & 1u) << 6));
    const bf16_t* kgp = Kg + ((size_t)b * SEQ + skv) * DM + head * 64 + 8 * sch;
    const bf16_t* vgp = Vg + ((size_t)b * SEQ + skv) * DM + head * 64 + 8 * sch;
    const unsigned krd0 = 128u * r32, krd1 = 128u * (r32 + 32);
    const int ksw0 = (r32 >> 1) & 7, ksw1 = ((r32 + 32) >> 1) & 7;
    const int g4 = lane >> 4, q4 = (lane >> 2) & 3, p4 = lane & 3;
    unsigned vrd[2][2];
#pragma unroll
    for (int e = 0; e < 2; ++e)
#pragma unroll
        for (int db = 0; db < 2; ++db) { const int row = 8 * e + 4 * hh + q4; const unsigned bytec = (unsigned)(32 * db + 16 * (g4 & 1) + 4 * p4) * 2u;
            vrd[e][db] = 128u * row + (bytec ^ (((unsigned)(row >> 1) & 1u) << 6)); }

    f32x16 oT[2];
#pragma unroll
    for (int d = 0; d < 2; ++d)
#pragma unroll
        for (int r = 0; r < 16; ++r) oT[d][r] = 0.f;
    float mrun = -1e30f, lrun = 0.f, Rrun = 0.f;

    const int jt_hi = 4 * qb + 3;
    u32x4 kreg0 = *(const u32x4*)(kgp + (size_t)(64 * jt_hi) * DM), vreg0 = *(const u32x4*)(vgp + (size_t)(64 * jt_hi) * DM);
    u32x4 kreg1 = *(const u32x4*)(kgp + (size_t)(64 * (jt_hi - 1)) * DM), vreg1 = *(const u32x4*)(vgp + (size_t)(64 * (jt_hi - 1)) * DM);
    if (tid == 0) misc[MO_Q / 4] = (int)__hip_atomic_fetch_add(qhead, 1u, __ATOMIC_RELAXED, __HIP_MEMORY_SCOPE_AGENT);
    bool stop = false, wdone = false;
    for (int P = jt_hi >> 1; P >= 0 && !stop; --P) {
        const int pb_ = (P & 1) * 16384;
        *(LAS u32x4*)(lds + OFF_K + pb_ + 8192 + kst) = kreg0; *(LAS u32x4*)(lds + OFF_V + pb_ + 8192 + vst) = vreg0;
        *(LAS u32x4*)(lds + OFF_K + pb_ + kst) = kreg1; *(LAS u32x4*)(lds + OFF_V + pb_ + vst) = vreg1;
        __syncthreads();
        if (TYPE == 0) { if (P < (jt_hi >> 1)) { bool alld = true;
#pragma unroll
                for (int w = 0; w < 8; ++w) alld = alld && (misc[(MO_VOTE / 4) + ((P + 1) & 1) * 8 + w] != 0);
                if (alld) break; } }
        if (P > 0) { kreg0 = *(const u32x4*)(kgp + (size_t)(64 * (2 * P - 1)) * DM); vreg0 = *(const u32x4*)(vgp + (size_t)(64 * (2 * P - 1)) * DM);
                     kreg1 = *(const u32x4*)(kgp + (size_t)(64 * (2 * P - 2)) * DM); vreg1 = *(const u32x4*)(vgp + (size_t)(64 * (2 * P - 2)) * DM); }
#pragma unroll 1
        for (int sub = 1; sub >= 0; --sub) {
        const int jt = 2 * P + sub; const int buf = 0; (void)buf;
        const int kv0 = 64 * jt;
        const bool active = (kv0 <= qhi) && !(TYPE == 0 && (kv0 >= qhi || wdone));
        if (active) {
            const LAS unsigned char* Kb = lds + OFF_K + pb_ + sub * 8192; const LAS unsigned char* Vb = lds + OFF_V + pb_ + sub * 8192;
            f32x16 p0, p1; bool negl = false;
            const bool full = (kv0 + 63 <= qlo);
            if (TYPE == 2) {
#pragma unroll
                for (int g = 0; g < 4; ++g) { const f32x4 b0 = *(const LAS f32x4*)(bias + kv0 + 8 * g + 4 * hh), b1 = *(const LAS f32x4*)(bias + kv0 + 32 + 8 * g + 4 * hh);
#pragma unroll
                    for (int j = 0; j < 4; ++j) { p0[4 * g + j] = b0[j]; p1[4 * g + j] = b1[j]; } }
            } else {
#pragma unroll
                for (int r = 0; r < 16; ++r) { p0[r] = 0.f; p1[r] = 0.f; }
            }
            bf16x8 kfa[4], kfb[4];
#pragma unroll
            for (int s = 0; s < 4; ++s) {
                kfa[s] = *(const LAS bf16x8*)(Kb + krd0 + (((2 * s + hh) ^ ksw0) << 4));
                kfb[s] = *(const LAS bf16x8*)(Kb + krd1 + (((2 * s + hh) ^ ksw1) << 4));
            }
            __builtin_amdgcn_sched_barrier(0);
#pragma unroll
            for (int s = 0; s < 4; ++s) {
                p0 = __builtin_amdgcn_mfma_f32_32x32x16_bf16(kfa[s], qf[s], p0, 0, 0, 0);
                p1 = __builtin_amdgcn_mfma_f32_32x32x16_bf16(kfb[s], qf[s], p1, 0, 0, 0);
            }
            if (TYPE == 0) {
                float x0[16], x1[16];
#pragma unroll
                for (int r = 0; r < 16; ++r) {
                    const float z0 = p0[r], z1 = p1[r];
                    float n0 = fminf(-z0, 0.f) - flog2(1.0f + fexp2(-fabsf(z0)));
                    float n1 = fminf(-z1, 0.f) - flog2(1.0f + fexp2(-fabsf(z1)));
                    if (!full) { const int kvp = kv0 + crow(r, hh); if (kvp >= tq) n0 = 0.f; if (kvp + 32 >= tq) n1 = 0.f; }
                    x0[r] = n0; x1[r] = n1; p0[r] = z0 + n0; p1[r] = z1 + n1;
                }
                float T[8], PGm[8];
#pragma unroll
                for (int g = 0; g < 4; ++g) { const float ga = (x0[4 * g] + x0[4 * g + 1]) + (x0[4 * g + 2] + x0[4 * g + 3]), gb = (x1[4 * g] + x1[4 * g + 1]) + (x1[4 * g + 2] + x1[4 * g + 3]);
                    const float pa = xhalf_get(ga, lane), pb2 = xhalf_get(gb, lane); T[g] = ga + pa; T[4 + g] = gb + pb2; PGm[g] = hh == 0 ? pa : 0.f; PGm[4 + g] = hh == 0 ? pb2 : 0.f; }
                float run = 0.f;
#pragma unroll
                for (int g = 7; g >= 0; --g) { const float lg = Rrun + run + PGm[g]; run += T[g]; T[g] = lg; }
                Rrun += run;
#pragma unroll
                for (int g = 0; g < 4; ++g) {
                    { const float b3 = T[g], b2 = b3 + x0[4 * g + 3], b1 = b2 + x0[4 * g + 2], b0 = b1 + x0[4 * g + 1];
                      p0[4 * g + 3] = fexp2(p0[4 * g + 3] + b3); p0[4 * g + 2] = fexp2(p0[4 * g + 2] + b2); p0[4 * g + 1] = fexp2(p0[4 * g + 1] + b1); p0[4 * g] = fexp2(p0[4 * g] + b0); }
                    { const float b3 = T[4 + g], b2 = b3 + x1[4 * g + 3], b1 = b2 + x1[4 * g + 2], b0 = b1 + x1[4 * g + 1];
                      p1[4 * g + 3] = fexp2(p1[4 * g + 3] + b3); p1[4 * g + 2] = fexp2(p1[4 * g + 2] + b2); p1[4 * g + 1] = fexp2(p1[4 * g + 1] + b1); p1[4 * g] = fexp2(p1[4 * g] + b0); }
                }
                if (!full) {
#pragma unroll
                    for (int r = 0; r < 16; ++r) { const int kvp = kv0 + crow(r, hh); if (kvp >= tq) p0[r] = 0.f; if (kvp + 32 >= tq) p1[r] = 0.f; }
                }
            } else {
                if (TYPE == 1) {
                const int dmin = qlo - (kv0 + 63), dmax = qhi - kv0;
                if (dmin > 512) {
#pragma unroll
                    for (int r = 0; r < 16; ++r) { const float c = LB_FAR(lbn[r]); p0[r] += c; p1[r] += c; }
                } else if (dmin > 128 && dmax <= 512) {
#pragma unroll
                    for (int r = 0; r < 16; ++r) { const float c = LB_MID(lbn[r]); p0[r] += c; p1[r] += c; }
                } else if (dmin >= 0 && dmax <= 128) {
#pragma unroll
                    for (int r = 0; r < 16; ++r) { p0[r] += lbn[r]; p1[r] += lbn[r]; }
                } else {
#pragma unroll
                    for (int r = 0; r < 16; ++r) { const int d0 = tq - (kv0 + crow(r, hh)), d1 = d0 - 32; const float vn = lbn[r], vm = LB_MID(vn), vf = LB_FAR(vn);
                        p0[r] += d0 < 0 ? -INFINITY : (d0 <= 128 ? vn : (d0 <= 512 ? vm : vf));
                        p1[r] += d1 < 0 ? -INFINITY : (d1 <= 128 ? vn : (d1 <= 512 ? vm : vf)); }
                }
                }
                if (TYPE == 2 && !full) {
#pragma unroll
                    for (int r = 0; r < 16; ++r) { const int kvp = kv0 + crow(r, hh); if (kvp > tq) p0[r] = -INFINITY; if (kvp + 32 > tq) p1[r] = -INFINITY; }
                }
                float mxa = max3f(p0[0], p0[1], p0[2]), mxb = max3f(p1[0], p1[1], p1[2]);
#pragma unroll
                for (int r = 3; r < 15; r += 2) { mxa = max3f(mxa, p0[r], p0[r + 1]); mxb = max3f(mxb, p1[r], p1[r + 1]); }
                float mx = max3f(mxa, mxb, fmaxf(p0[15], p1[15]));
                negl = (TYPE == 2) && __all(mx < mrun - 40.0f);
                if (!negl) {
                if (__any(mx > mrun + 8.0f)) {
                    mx = fmaxf(mx, xhalf_get(mx, lane));
                    const float mnew = (mx > mrun + 8.0f) ? mx : mrun, alpha = fexp2(mrun - mnew); mrun = mnew;
                    lrun = lrun * alpha;
#pragma unroll
                    for (int d = 0; d < 2; ++d)
#pragma unroll
                        for (int r = 0; r < 16; ++r) oT[d][r] *= alpha;
                }
#pragma unroll
                for (int r = 0; r < 16; ++r) { p0[r] = fexp2(p0[r] - mrun); p1[r] = fexp2(p1[r] - mrun); }
                }
            }
            if (!negl) {
            bf16x8 pb[4];
#pragma unroll
            for (int s = 0; s < 4; ++s) { const f32x16& pp = (s < 2) ? p0 : p1; const int o8 = 8 * (s & 1);
                u32x4 w; w.x = pk2(pp[o8 + 0], pp[o8 + 1]); w.y = pk2(pp[o8 + 2], pp[o8 + 3]); w.z = pk2(pp[o8 + 4], pp[o8 + 5]); w.w = pk2(pp[o8 + 6], pp[o8 + 7]);
                pb[s] = __builtin_bit_cast(bf16x8, w); }
            bf16x8 va[4][2];
#pragma unroll
            for (int s = 0; s < 4; ++s)
#pragma unroll
                for (int db = 0; db < 2; ++db) {
                    const s16x4 lo = __builtin_amdgcn_ds_read_tr16_b64_v4i16((LAS s16x4*)(Vb + vrd[0][db] + 2048u * s));
                    const s16x4 hi = __builtin_amdgcn_ds_read_tr16_b64_v4i16((LAS s16x4*)(Vb + vrd[1][db] + 2048u * s));
                    va[s][db] = (bf16x8){lo[0], lo[1], lo[2], lo[3], hi[0], hi[1], hi[2], hi[3]};
                }
            __builtin_amdgcn_sched_barrier(0);
            if (TYPE != 0) {
                f32x16 rs;
#pragma unroll
                for (int r = 0; r < 16; ++r) rs[r] = 0.f;
                const bf16x8 ones = (bf16x8){0x3F80, 0x3F80, 0x3F80, 0x3F80, 0x3F80, 0x3F80, 0x3F80, 0x3F80};
#pragma unroll
                for (int s = 0; s < 4; ++s) rs = __builtin_amdgcn_mfma_f32_32x32x16_bf16(ones, pb[s], rs, 0, 0, 0);
                lrun += rs[0];
            }
#pragma unroll
            for (int s = 0; s < 4; ++s)
#pragma unroll
                for (int db = 0; db < 2; ++db) oT[db] = __builtin_amdgcn_mfma_f32_32x32x16_bf16(va[s][db], pb[s], oT[db], 0, 0, 0);
            }
        }
        if (TYPE == 0 && sub == 0) {
            const bool done = wdone || (active && __all(Rrun < -64.0f));
            wdone = done;
            if (lane == 0) misc[(MO_VOTE / 4) + (P & 1) * 8 + wid] = done ? 1 : 0;
        }
        }
    }
    float inv = 1.0f;
    if (TYPE != 0) { inv = frcp(lrun); }
    if (FUSE_ONORM) {
        float ssq = 0.f;
#pragma unroll
        for (int db = 0; db < 2; ++db)
#pragma unroll
            for (int r = 0; r < 16; ++r) { const float ov = oT[db][r] * inv; ssq += ov * ov; }
        const float sp = xhalf_get(ssq, lane); const float tot = hh == 0 ? ssq + sp : sp + ssq;
        if (hh == 0) ssrow[16 * grow + head] = tot;
    }
    bf16_t* op = O + grow * DM + head * 64 + 4 * hh;
#pragma unroll
    for (int db = 0; db < 2; ++db)
#pragma unroll
        for (int g = 0; g < 4; ++g) { u32x2 w; w.x = pk2(oT[db][4 * g] * inv, oT[db][4 * g + 1] * inv); w.y = pk2(oT[db][4 * g + 2] * inv, oT[db][4 * g + 3] * inv);
            *(u32x2*)(op + 32 * db + 8 * g) = w; }
    __syncthreads();
}
}

constexpr int N_PHASES = 2 + 8 * DEPTH;

struct Row16 { float v[16]; };
__device__ __forceinline__ Row16 ld_row_f32(const float* p, int lane) { Row16 r; const f32x4 a = *(const f32x4*)(p + 8 * lane), b = *(const f32x4*)(p + 8 * lane + 4), c = *(const f32x4*)(p + 512 + 8 * lane), d = *(const f32x4*)(p + 516 + 8 * lane);
#pragma unroll
    for (int i = 0; i < 4; ++i) { r.v[i] = a[i]; r.v[4 + i] = b[i]; r.v[8 + i] = c[i]; r.v[12 + i] = d[i]; } return r; }
__device__ __forceinline__ void st_row_f32(float* p, int lane, const Row16& r) {
    *(f32x4*)(p + 8 * lane) = (f32x4){r.v[0], r.v[1], r.v[2], r.v[3]}; *(f32x4*)(p + 8 * lane + 4) = (f32x4){r.v[4], r.v[5], r.v[6], r.v[7]};
    *(f32x4*)(p + 512 + 8 * lane) = (f32x4){r.v[8], r.v[9], r.v[10], r.v[11]}; *(f32x4*)(p + 516 + 8 * lane) = (f32x4){r.v[12], r.v[13], r.v[14], r.v[15]}; }
__device__ __forceinline__ Row16 ld_row_bf16(const bf16_t* p, int lane) { Row16 r; const u32x4 a = *(const u32x4*)(p + 8 * lane), c = *(const u32x4*)(p + 512 + 8 * lane);
    r.v[0] = bf_lo(a.x); r.v[1] = bf_hi(a.x); r.v[2] = bf_lo(a.y); r.v[3] = bf_hi(a.y); r.v[4] = bf_lo(a.z); r.v[5] = bf_hi(a.z); r.v[6] = bf_lo(a.w); r.v[7] = bf_hi(a.w);
    r.v[8] = bf_lo(c.x); r.v[9] = bf_hi(c.x); r.v[10] = bf_lo(c.y); r.v[11] = bf_hi(c.y); r.v[12] = bf_lo(c.z); r.v[13] = bf_hi(c.z); r.v[14] = bf_lo(c.w); r.v[15] = bf_hi(c.w); return r; }
__device__ __forceinline__ void st_row_bf16(bf16_t* p, int lane, const Row16& r) { u32x4 a, c;
    a.x = pk2(r.v[0], r.v[1]); a.y = pk2(r.v[2], r.v[3]); a.z = pk2(r.v[4], r.v[5]); a.w = pk2(r.v[6], r.v[7]);
    c.x = pk2(r.v[8], r.v[9]); c.y = pk2(r.v[10], r.v[11]); c.z = pk2(r.v[12], r.v[13]); c.w = pk2(r.v[14], r.v[15]);
    *(u32x4*)(p + 8 * lane) = a; *(u32x4*)(p + 512 + 8 * lane) = c; }

__device__ __forceinline__ Row16 norm_mod(const Row16& x, const float* g, const float* sh, const float* sc, int lane) {
    float ss = 0.f;
#pragma unroll
    for (int i = 0; i < 16; ++i) ss += x.v[i] * x.v[i];
    const float rinv = frsq(wave_sum(ss) * (1.0f / DM) + EPS);
    const Row16 G = ld_row_f32(g, lane), SH = ld_row_f32(sh, lane), SC = ld_row_f32(sc, lane); Row16 h;
#pragma unroll
    for (int i = 0; i < 16; ++i) h.v[i] = (x.v[i] * rinv) * G.v[i] * (1.0f + SC.v[i]) + SH.v[i];
    return h;
}

__device__ __forceinline__ Row16 norm_pre(const Row16& x, const Row16& GS, const Row16& SH) {
    float ss = 0.f;
#pragma unroll
    for (int i = 0; i < 16; ++i) ss += x.v[i] * x.v[i];
    const float rinv = frsq(wave_sum(ss) * (1.0f / DM) + EPS); Row16 h;
#pragma unroll
    for (int i = 0; i < 16; ++i) h.v[i] = (x.v[i] * rinv) * GS.v[i] + SH.v[i];
    return h;
}
__device__ __forceinline__ void ld_gs_sh(const float* g, const float* sh, const float* sc, int lane, Row16& GS, Row16& SH) {
    const Row16 G = ld_row_f32(g, lane), SC = ld_row_f32(sc, lane); SH = ld_row_f32(sh, lane);
#pragma unroll
    for (int i = 0; i < 16; ++i) GS.v[i] = G.v[i] * (1.0f + SC.v[i]);
}
struct Raw8 { u32x4 a, c; };
__device__ __forceinline__ Raw8 ld_raw_bf16(const bf16_t* p, int lane) { Raw8 r; r.a = *(const u32x4*)(p + 8 * lane); r.c = *(const u32x4*)(p + 512 + 8 * lane); return r; }
__device__ __forceinline__ void acc_raw(Row16& s, const Raw8& r) {
    s.v[0] += bf_lo(r.a.x); s.v[1] += bf_hi(r.a.x); s.v[2] += bf_lo(r.a.y); s.v[3] += bf_hi(r.a.y); s.v[4] += bf_lo(r.a.z); s.v[5] += bf_hi(r.a.z); s.v[6] += bf_lo(r.a.w); s.v[7] += bf_hi(r.a.w);
    s.v[8] += bf_lo(r.c.x); s.v[9] += bf_hi(r.c.x); s.v[10] += bf_lo(r.c.y); s.v[11] += bf_hi(r.c.y); s.v[12] += bf_lo(r.c.z); s.v[13] += bf_hi(r.c.z); s.v[14] += bf_lo(r.c.w); s.v[15] += bf_hi(r.c.w); }

struct Raw8f { u32x2 a, c; };
__device__ __forceinline__ Raw8f ld_raw_fp8(const unsigned char* p, int lane) { Raw8f r; r.a = *(const u32x2*)(p + 8 * lane); r.c = *(const u32x2*)(p + 512 + 8 * lane); return r; }
__device__ __forceinline__ void acc_raw8(Row16& s, const Raw8f& r) {
    const unsigned w[4] = {r.a.x, r.a.y, r.c.x, r.c.y};
#pragma unroll
    for (int q = 0; q < 4; ++q) { const f32x2 lo = __builtin_amdgcn_cvt_pk_f32_fp8((int)w[q], false), hi = __builtin_amdgcn_cvt_pk_f32_fp8((int)w[q], true);
        s.v[4 * q] += lo[0]; s.v[4 * q + 1] += lo[1]; s.v[4 * q + 2] += hi[0]; s.v[4 * q + 3] += hi[1]; } }

__device__ __forceinline__ void st_row_h1(bf16_t* hb, unsigned char* hb8, size_t m, int lane, const Row16& h) {
    if (QKV_FP8 != 0) { u32x2 a, c; a.x = pk4_fp8(h.v[0], h.v[1], h.v[2], h.v[3]); a.y = pk4_fp8(h.v[4], h.v[5], h.v[6], h.v[7]); c.x = pk4_fp8(h.v[8], h.v[9], h.v[10], h.v[11]); c.y = pk4_fp8(h.v[12], h.v[13], h.v[14], h.v[15]);
        unsigned char* p = hb8 + m * DM; *(u32x2*)(p + 8 * lane) = a; *(u32x2*)(p + 512 + 8 * lane) = c; }
    if (QKV_FP8 != 1) st_row_bf16(hb + m * DM, lane, h);
}
__device__ __forceinline__ void forget_logits(const Row16& h, const LAS float* wf, const float* bfg, float* lf2, int b, int t, int lane) {
    float fl[6];
#pragma unroll
    for (int j = 0; j < 6; ++j) { const LAS float* w = wf + j * DM; const f32x4 a = *(const LAS f32x4*)(w + 8 * lane), bq = *(const LAS f32x4*)(w + 8 * lane + 4), c = *(const LAS f32x4*)(w + 512 + 8 * lane), d = *(const LAS f32x4*)(w + 516 + 8 * lane);
        float s = 0.f;
#pragma unroll
        for (int i = 0; i < 4; ++i) s += h.v[i] * a[i] + h.v[4 + i] * bq[i] + h.v[8 + i] * c[i] + h.v[12 + i] * d[i];
        fl[j] = wave_sum(s); }
    if (lane < 6) { float y = fl[0];
#pragma unroll
        for (int j = 1; j < 6; ++j) y = (lane == j) ? fl[j] : y;
        y += bfg[lane];
        const float y2 = y * LOG2E; const float ls2 = fminf(y2, 0.f) - flog2(1.0f + fexp2(-fabsf(y2)));
        lf2[((size_t)b * 6 + lane) * SEQ + t] = ls2; }
}
__device__ __forceinline__ void stage_wf(LAS float* wf, const float* w_in_l, int tid) {
    for (int i = tid; i < 6 * DM; i += NTHREADS) { const int j = i / DM, k = i % DM; wf[i] = w_in_l[(size_t)k * NIN + 3072 + j]; }
}

template <int MAP>
__device__ __forceinline__ int wrow_map(int n) {
    if (MAP == 1) { const int region = n >> 10, cn = n & 1023, head = cn >> 6, dd = cn & 63; if (region < 2 && head >= 4 && head < 10) return (region << 10) + (head << 6) + 2 * (dd & 31) + (dd >> 5); return n; }
    if (MAP == 2) { const int half = n >> 10, jn = n & 1023; return 256 * (jn >> 7) + 128 * half + (jn & 127); }
    if (MAP == 3) { const int l = n & 255, wc = l >> 6, rem = l & 63, fq = rem >> 4, bj = (rem >> 3) & 1, c = rem & 7; return (n & ~255) + 128 * bj + 32 * wc + 8 * fq + c; }
    return n;
}
template <int MAP>
__device__ __forceinline__ void transpose_item_fp8(const float* W, int ldw, int k0, int n0, unsigned char* WT, int lane) {
    const int g = lane >> 3, cq = lane & 7;
    f32x4 v[16];
#pragma unroll
    for (int i = 0; i < 16; ++i) v[i] = *(const f32x4u*)(W + (size_t)(k0 + 16 * g + i) * ldw + n0 + 4 * cq) * 32.0f;
#pragma unroll
    for (int c = 0; c < 4; ++c) { const int prow = wrow_map<MAP>(n0 + 4 * cq + c); u32x4 a;
        a.x = pk4_fp8(v[0][c], v[1][c], v[2][c], v[3][c]); a.y = pk4_fp8(v[4][c], v[5][c], v[6][c], v[7][c]); a.z = pk4_fp8(v[8][c], v[9][c], v[10][c], v[11][c]); a.w = pk4_fp8(v[12][c], v[13][c], v[14][c], v[15][c]);
        *(u32x4*)(WT + (size_t)prow * DM + k0 + 16 * g) = a; }
}
template <int MAP, bool SCALE>
__device__ __forceinline__ void transpose_item(const float* W, int ldw, int k0, int n0, bf16_t* WT, const float* ks, int lane) {
    const int g = lane >> 4, cq = lane & 15;
    f32x4 v[16];
#pragma unroll
    for (int i = 0; i < 16; ++i) v[i] = *(const f32x4u*)(W + (size_t)(k0 + 16 * g + i) * ldw + n0 + 4 * cq);
    if (SCALE) {
#pragma unroll
        for (int i = 0; i < 16; ++i) v[i] = v[i] * ks[k0 + 16 * g + i];
    }
#pragma unroll
    for (int c = 0; c < 4; ++c) { const int prow = wrow_map<MAP>(n0 + 4 * cq + c); u32x4 a, bq;
        a.x = pk2(v[0][c], v[1][c]); a.y = pk2(v[2][c], v[3][c]); a.z = pk2(v[4][c], v[5][c]); a.w = pk2(v[6][c], v[7][c]);
        bq.x = pk2(v[8][c], v[9][c]); bq.y = pk2(v[10][c], v[11][c]); bq.z = pk2(v[12][c], v[13][c]); bq.w = pk2(v[14][c], v[15][c]);
        bf16_t* op = WT + (size_t)prow * DM + k0 + 16 * g; *(u32x4*)op = a; *(u32x4*)(op + 8) = bq; }
}


#define x_in   (INF(0))
#define c_in   (INF(1))
#define pos_in ((const int*)INF(2))
#define w_mod  (INF(3))
#define b_mod  (INF(4))
#define g_attn (INF(5))
#define w_in   (INF(6))
#define b_forget (INF(7))
#define g_mix  (INF(8))
#define w_out  (INF(9))
#define g_ffn  (INF(10))
#define w_router (INF(11))
#define b_router (INF(12))
#define w_gu   (INF(13))
#define b_gu   (INF(14))
#define w_dn   (INF(15))
#define b_dn   (INF(16))
#define g_final (INF(17))
#define xres   (ka->out)
#define MOD    WSP(float, WS_MOD)
#define ROPE   WSP(float, WS_ROPE)
#define LF2    WSP(float, WS_LF2)
#define TOPG   WSP(float, WS_TOPG)
#define WRT    WSP(float, WS_WRT)
#define LIST   WSP(int, WS_LIST)
#define POSE   WSP(int, WS_POSE)
#define WIN    WSP(bf16_t, WS_WIN)
#define WOUT   WSP(bf16_t, WS_WOUT)
#define WGU    WSP(bf16_t, WS_WGU)
#define WDN    WSP(bf16_t, WS_WDN)
#define HB     WSP(bf16_t, WS_H)
#define XB16   WSP(bf16_t, WS_X16)
#define HB8    WSP(unsigned char, WS_H8)
#define QB     WSP(bf16_t, WS_Q)
#define KB     WSP(bf16_t, WS_K)
#define VB     WSP(bf16_t, WS_V)
#define OB     WSP(bf16_t, WS_O)
#define ACT    WSP(bf16_t, WS_ACT)
#define OUTB   WSP(bf16_t, WS_OUTB)
#define modL   (MOD + (size_t)L * NB * (NMOD * DM))
#define SSL    WSP(float, WS_SS)

#define PHASE_LOCALS \
    LAS unsigned char* lds = (LAS unsigned char*)lds_raw; \
    volatile LAS int* misc = (volatile LAS int*)(lds + MISC_OFF); (void)misc; \
    int wv_ = wave_arg; asm volatile("" : "+s"(wv_)); const int wave = wv_; int tid_ = 64 * wave + lane_id(); asm volatile("" : "+v"(tid_)); const int tid = tid_, lane = tid & 63; (void)lane; \
    int blk_ = blockIdx.x, G_ = gridDim.x; asm volatile("" : "+s"(blk_), "+s"(G_)); const int G = G_, blk = blk_; \
    const int gw = blk * NWAVES + wave, NGW = G * NWAVES; (void)gw; (void)NGW; \
    kargs_t ka = KA(); gu32* ctl = (gu32*)(ka->ws + WS_CTL); (void)ctl;
#define PHASE_FN __device__ __forceinline__ void

__device__ __forceinline__ void expert_prefix(volatile LAS int* misc, gu32* ctl, int L, int tid) {
    if (tid < 64) { const int e = tid & 31;
        const int c = (int)__hip_atomic_load(ctl + CW_GCNT + 64 * L + e, __ATOMIC_RELAXED, __HIP_MEMORY_SCOPE_AGENT);
        const int t = (c + 255) >> 8; int inc = t;
#pragma unroll
        for (int o = 1; o < 32; o <<= 1) { const int v = __builtin_amdgcn_ds_bpermute(((tid & 63) - o) << 2, inc); if (e >= o) inc += v; }
        if (tid < 32) { misc[(MO_CNT / 4) + e] = c; misc[(MO_PRE / 4) + e] = inc - t; if (e == 31) misc[(MO_PRE / 4) + NE] = inc; } }
}
constexpr int CV_GU = 32 * 16 * 32, CV_DN = 32 * 16 * 16, CV_M = CV_GU + CV_DN, CV_DEF = 8192, CV_KEEP = CV_M - CV_DEF, CV_BATCH = 3;
static_assert(CV_KEEP >= CV_GU, "the deferred items are all w_dn items");
__device__ __forceinline__ void conv_deferred(kargs_t ka, gu32* ctl, int L, int visits, int wave, int lane, volatile LAS int* slot) {
    gu32* head = ctl + CW_CONV + 64 * L;
    for (int v = 0; v < visits; ++v) {
        if (wave == 0 && lane == 0) slot[0] = (int)__hip_atomic_fetch_add(head, (unsigned)(8 * CV_BATCH), __ATOMIC_RELAXED, __HIP_MEMORY_SCOPE_AGENT);
        __syncthreads();
        const int base = __builtin_amdgcn_readfirstlane(slot[0]);
        __syncthreads();
        if (base >= CV_DEF) break;
        for (int k = 0; k < CV_BATCH; ++k) { const int d = base + wave * CV_BATCH + k; if (d >= CV_DEF) break;
            const int r = CV_KEEP + d - CV_GU, e = r / 256, q = r % 256;
            transpose_item_fp8<3>(ka->in[15] + ((size_t)L * NE + e) * DM * DM, DM, 128 * (q / 32), 32 * (q % 32), ka->ws + WS_WDN + ((size_t)L * NE + e) * DM * DM, lane); }
    }
}
PHASE_FN phase_prologue(int wave_arg) { PHASE_LOCALS

        constexpr int I_IN = 16 * 48, I_OUT = 16 * 16, I_GU = 32 * 16 * 32, I_DN = 32 * 16 * 16, I_S = I_IN + I_OUT, I_M = I_GU + I_DN;
        for (int it = gw; it < DEPTH * I_S; it += NGW) {
            const int L = it / I_S; int r = it % I_S;
            if (r < I_IN) { const int kb = r / 48, nb = r % 48; if (QKV_FP8 != 0) transpose_item_fp8<1>(w_in + (size_t)L * DM * NIN, NIN, 128 * (r / 96), 32 * (r % 96), WSP(unsigned char, WS_WIN8) + (size_t)L * 3072 * DM, lane); if (QKV_FP8 != 1) transpose_item<1, false>(w_in + (size_t)L * DM * NIN, NIN, 64 * kb, 64 * nb, WIN + (size_t)L * 3072 * DM, nullptr, lane); continue; } r -= I_IN;
            { const int kb = r / 16, nb = r % 16; transpose_item<0, true>(w_out + (size_t)L * DM * DM, DM, 64 * kb, 64 * nb, WOUT + (size_t)L * DM * DM, g_mix + (size_t)L * DM, lane); }
        }
        if (MOE_FP8) {
            struct TItem { const float* src; unsigned char* dst; int ldw, nn, gu; };
            constexpr int KEEPR = EPI_CONV ? I_M : CV_KEEP;
            auto mk = [&](int j) -> TItem { TItem t; int L = 0, r = j; if (j >= I_M) { const int jj = j - I_M; L = 1 + jj / KEEPR; r = jj % KEEPR; } const int g = lane >> 3, cq = lane & 7;
                if (r < I_GU) { const int e = r / 512, q = r % 512, k0 = 128 * (q / 64), n0 = 32 * (q % 64); t.ldw = 2048; t.gu = 1; t.nn = n0 + 4 * cq;
                    t.src = w_gu + ((size_t)L * NE + e) * DM * 2048 + (size_t)(k0 + 16 * g) * 2048 + n0 + 4 * cq; t.dst = (unsigned char*)WGU + ((size_t)L * NE + e) * 2048 * DM + k0 + 16 * g; }
                else { r -= I_GU; const int e = r / 256, q = r % 256, k0 = 128 * (q / 32), n0 = 32 * (q % 32); t.ldw = DM; t.gu = 0; t.nn = n0 + 4 * cq;
                    t.src = w_dn + ((size_t)L * NE + e) * DM * DM + (size_t)(k0 + 16 * g) * DM + n0 + 4 * cq; t.dst = (unsigned char*)WDN + ((size_t)L * NE + e) * DM * DM + k0 + 16 * g; }
                return t; };
#define TI_LOAD(V, T) _Pragma("unroll") for (int i = 0; i < 16; ++i) V[i] = *(const f32x4u*)((T).src + (size_t)i * (T).ldw);
#define TI_STORE(V, T) _Pragma("unroll") for (int c = 0; c < 4; ++c) { const int n_ = (T).nn + c; const int prow = (T).gu ? wrow_map<2>(n_) : wrow_map<3>(n_); u32x4 a; \
                a.x = pk4_fp8(V[0][c] * 32.0f, V[1][c] * 32.0f, V[2][c] * 32.0f, V[3][c] * 32.0f); a.y = pk4_fp8(V[4][c] * 32.0f, V[5][c] * 32.0f, V[6][c] * 32.0f, V[7][c] * 32.0f); \
                a.z = pk4_fp8(V[8][c] * 32.0f, V[9][c] * 32.0f, V[10][c] * 32.0f, V[11][c] * 32.0f); a.w = pk4_fp8(V[12][c] * 32.0f, V[13][c] * 32.0f, V[14][c] * 32.0f, V[15][c] * 32.0f); \
                *(u32x4*)((T).dst + (size_t)prow * DM) = a; }
            static_assert(I_M == CV_M && I_GU == CV_GU, "item spaces");
            const int TOT = (EPI_CONV && G == 256) ? I_GU : I_M + (DEPTH - 1) * KEEPR;
            f32x4 va[16], vb[16];
            TItem A = mk(gw), B = A;
            if (gw < TOT) { TI_LOAD(va, A) }
            for (int j = gw; j < TOT; j += 2 * NGW) {
                const bool hb = (j + NGW < TOT);
                if (hb) { B = mk(j + NGW); TI_LOAD(vb, B) }
                TI_STORE(va, A)
                if (j + 2 * NGW < TOT) { A = mk(j + 2 * NGW); TI_LOAD(va, A) }
                if (hb) { TI_STORE(vb, B) }
            }
#undef TI_LOAD
#undef TI_STORE
        } else {
            for (int it = gw; it < DEPTH * I_M; it += NGW) { const int L = it / I_M; int r = it % I_M;
                if (r < I_GU) { const int e = r / 512, q = r % 512, kb = q / 32, nb = q % 32; transpose_item<2, false>(w_gu + ((size_t)L * NE + e) * DM * 2048, 2048, 64 * kb, 64 * nb, WGU + ((size_t)L * NE + e) * 2048 * DM, nullptr, lane); continue; } r -= I_GU;
                { const int e = r / 256, q = r % 256, kb = q / 16, nb = q % 16; transpose_item<0, false>(w_dn + ((size_t)L * NE + e) * DM * DM, DM, 64 * kb, 64 * nb, WDN + ((size_t)L * NE + e) * DM * DM, nullptr, lane); }
            }
        }
        for (int i = blk * NTHREADS + tid; i < DEPTH * NE * DM; i += G * NTHREADS) { const int L = i / (NE * DM), r = i % (NE * DM), e = r / DM, k = r % DM; WRT[i] = w_router[((size_t)L * DM + k) * NE + e]; }
        for (int i = blk * NTHREADS + tid; i < NTOK * 32; i += G * NTHREADS) {
            const int row = i >> 5, j = i & 31;
            const float invf = fexp2(-(float)j * (13.287712379549449f / 32.0f));
            const float ang = (float)pos_in[row] * invf;
            const double a = (double)ang; const double kq = rint(a * 0.63661977236758134308); const double r = fma(-kq, 1.57079632679489661923, a), r2 = r * r;
            const double sn = r * (1.0 + r2 * (-1.0 / 6 + r2 * (1.0 / 120 + r2 * (-1.0 / 5040 + r2 * (1.0 / 362880 + r2 * (-1.0 / 39916800))))));
            const double cs = 1.0 + r2 * (-0.5 + r2 * (1.0 / 24 + r2 * (-1.0 / 720 + r2 * (1.0 / 40320 + r2 * (-1.0 / 3628800 + r2 * (1.0 / 479001600))))));
            const int qd = ((int)kq) & 3; double c, s;
            if (qd == 0) { c = cs; s = sn; } else if (qd == 1) { c = -sn; s = cs; } else if (qd == 2) { c = -cs; s = -sn; } else { c = sn; s = -cs; }
            ROPE[2 * (size_t)i] = (float)c; ROPE[2 * (size_t)i + 1] = (float)s;
        }
        {
            LAS float* cact = (LAS float*)(lds);
            LAS float* red = (LAS float*)(lds + 65536);
            for (int i = lane; i < 128 * 16; i += 64) { const int bb = i >> 7, kk = i & 127; const float cv = c_in[bb * DM + 128 * wave + kk]; cact[wave * 2048 + kk * 16 + bb] = cv * frcp(1.0f + fexp2(-cv * LOG2E)); }
            __syncthreads();
            for (int tk = blk; tk < DEPTH * 96; tk += G) {
                const int L = tk / 96, j0 = 64 * (tk % 96);
                const float* wp = w_mod + ((size_t)L * DM + 128 * wave) * (NMOD * DM) + j0 + lane;
                float acc[16];
#pragma unroll
                for (int bb = 0; bb < 16; ++bb) acc[bb] = 0.f;
#pragma unroll 1
                for (int kb = 0; kb < 128; kb += 16) {
                    float wv[16];
#pragma unroll
                    for (int i = 0; i < 16; ++i) wv[i] = wp[(size_t)(kb + i) * (NMOD * DM)];
#pragma unroll
                    for (int i = 0; i < 16; ++i) { const LAS f32x4* cp = (const LAS f32x4*)(cact + wave * 2048 + (kb + i) * 16);
#pragma unroll
                        for (int q = 0; q < 4; ++q) { const f32x4 cc = cp[q]; acc[4 * q] += wv[i] * cc[0]; acc[4 * q + 1] += wv[i] * cc[1]; acc[4 * q + 2] += wv[i] * cc[2]; acc[4 * q + 3] += wv[i] * cc[3]; }
                        if ((i & 3) == 3) __builtin_amdgcn_sched_barrier(0); } }
#pragma unroll
                for (int bb = 0; bb < 16; ++bb) red[(wave * 16 + bb) * 64 + lane] = acc[bb];
                __syncthreads();
                for (int o = tid; o < 1024; o += NTHREADS) { const int bb = o >> 6, cl = o & 63; float s = 0.f;
#pragma unroll
                    for (int w = 0; w < 8; ++w) s += red[(w * 16 + bb) * 64 + cl];
                    MOD[((size_t)L * NB + bb) * (NMOD * DM) + j0 + cl] = s + b_mod[(size_t)L * (NMOD * DM) + j0 + cl]; }
                __syncthreads();
            }
        }
    }
PHASE_FN phase_norm0(int wave_arg) { PHASE_LOCALS
    LAS float* wf = (LAS float*)lds; stage_wf(wf, w_in, tid); __syncthreads();
    const int RPW = NTOK / NGW;
    if (RPW * NGW == NTOK && (RPW & 1) == 0 && (SEQ % RPW) == 0) {
        const int m0 = gw * RPW, b = m0 >> 11; const float* modb = MOD + (size_t)b * (NMOD * DM);
        Row16 GS, SH; ld_gs_sh(g_attn, modb, modb + DM, lane, GS, SH);
        for (int m = m0; m < m0 + RPW; m += 2) {
            const Row16 xa = ld_row_f32(x_in + (size_t)m * DM, lane), xb = ld_row_f32(x_in + (size_t)(m + 1) * DM, lane);
            const Row16 ha = norm_pre(xa, GS, SH), hb = norm_pre(xb, GS, SH);
            st_row_h1(HB, HB8, (size_t)m, lane, ha); st_row_h1(HB, HB8, (size_t)(m + 1), lane, hb);
            forget_logits(ha, wf, b_forget, LF2, b, m & (SEQ - 1), lane); forget_logits(hb, wf, b_forget, LF2, b, (m + 1) & (SEQ - 1), lane); }
    } else {
        for (int m = gw; m < NTOK; m += NGW) { const int b = m >> 11, t = m & (SEQ - 1); const float* modb = MOD + (size_t)b * (NMOD * DM);
            const Row16 x = ld_row_f32(x_in + (size_t)m * DM, lane); const Row16 h = norm_mod(x, g_attn, modb, modb + DM, lane);
            st_row_h1(HB, HB8, (size_t)m, lane, h); forget_logits(h, wf, b_forget, LF2, b, t, lane); }
    }
    __syncthreads();
}
PHASE_FN phase_qkv(int L_, int wave_arg, int dry_ = 0) { const int L = __builtin_amdgcn_readfirstlane(L_); const bool dry = __builtin_amdgcn_readfirstlane(dry_) != 0; PHASE_LOCALS

            if (QKV_FP8 != 1) {
                pg8::StaticOrder S; S.init(HB, WIN + (size_t)L * 3072 * DM, NTOK, 3072, G, blk); if (QKV_FP8 == 2) S.restrict_cols(0xBA98ull, 4);
                pg8::EpiQKV E{QB, ROPE, 1.0f};
                pg8::gemm_phase<pg8::EpiQKV, pg8::StaticOrder, false>(lds, wave, S, E, dry); }
            if (QKV_FP8 != 0) {
                pg8::StaticOrderT<pg8::KK> S; S.init(HB8, WSP(unsigned char, WS_WIN8) + (size_t)L * 3072 * DM, NTOK, 3072, G, blk); if (QKV_FP8 == 2) S.restrict_cols(0x76543210ull, 8);
                pg8::EpiQKV E{QB, ROPE, 1.0f / 32.0f};
                pg8::gemm_phase<pg8::EpiQKV, pg8::StaticOrderT<pg8::KK>, false, true>(lds, wave, S, E, dry); }
        }
PHASE_FN phase_attn(int L_, int rep_, int wave_arg) { const int L = __builtin_amdgcn_readfirstlane(L_), rep = __builtin_amdgcn_readfirstlane(rep_); PHASE_LOCALS

    volatile LAS int* qslot = misc + (MO_Q / 4);
#define ATT_QUEUE(QI, NUNITS, ...) do { gu32* head = ctl + CW_AQ + 64 * (3 * L + (QI)) + 1024 * rep; \
        if (tid == 0) qslot[0] = (int)__hip_atomic_fetch_add(head, 1u, __ATOMIC_RELAXED, __HIP_MEMORY_SCOPE_AGENT); \
        __syncthreads(); \
        for (;;) { const int idx = qslot[0]; __syncthreads(); if (idx >= (NUNITS)) break; \
            int tl = tid; asm volatile("" : "+v"(tl)); __VA_ARGS__ } __syncthreads(); } while (0)
    const int amask = rep ? REP_ATT_MASK : 7;
    if (amask & 2) ATT_QUEUE(0, 768, { const int qb = 7 - idx / 96, rem = idx % 96, b = rem / 6, hd = 4 + rem % 6; att::attn_unit<1>(lds, misc, QB, KB, VB, OB, nullptr, SSL, b, hd, qb, tl, head); });
    if (amask & 4) ATT_QUEUE(1, 768, { const int qb = 7 - idx / 96, rem = idx % 96, b = rem / 6, hd = 10 + rem % 6; att::attn_unit<2>(lds, misc, QB, KB, VB, OB, LF2 + ((size_t)b * 6 + (hd - 10)) * SEQ, SSL, b, hd, qb, tl, head); });
    if (amask & 1) ATT_QUEUE(2, 512, { const int qb = 7 - idx / 64, b = (idx % 64) / 4, hd = idx % 4; att::attn_unit<0>(lds, misc, QB, KB, VB, OB, nullptr, SSL, b, hd, qb, tl, head); });
#undef ATT_QUEUE
}
PHASE_FN phase_onorm(int L_, int wave_arg) { const int L = __builtin_amdgcn_readfirstlane(L_); PHASE_LOCALS
    (void)L;
    const int RPW = (NTOK + NGW - 1) / NGW, m0 = gw * RPW, m1 = (m0 + RPW < NTOK) ? m0 + RPW : NTOK;
    for (int m = m0; m < m1; m += 4) {
        Raw8 r[4];
#pragma unroll
        for (int j = 0; j < 4; ++j) if (m + j < m1) r[j] = ld_raw_bf16(OB + (size_t)(m + j) * DM, lane);
#pragma unroll
        for (int j = 0; j < 4; ++j) if (m + j < m1) {
            Row16 o;
#pragma unroll
            for (int i = 0; i < 16; ++i) o.v[i] = 0.f;
            acc_raw(o, r[j]);
            float sa = 0.f, sb = 0.f;
#pragma unroll
            for (int i = 0; i < 8; ++i) { sa += o.v[i] * o.v[i]; sb += o.v[8 + i] * o.v[8 + i]; }
            const float s0 = wave_sum(lane < 32 ? sa : 0.f), s1 = wave_sum((lane >= 32 ? sa : 0.f) + (lane < 16 ? sb : 0.f)), s2 = wave_sum(lane >= 16 ? sb : 0.f);
            const float r0 = frsq(s0 * (1.0f / 256) + EPS), r1 = frsq(s1 * (1.0f / 384) + EPS), r2 = frsq(s2 * (1.0f / 384) + EPS);
            const float fa = lane < 32 ? r0 : r1, fb = lane < 16 ? r1 : r2;
#pragma unroll
            for (int i = 0; i < 8; ++i) { o.v[i] *= fa; o.v[8 + i] *= fb; }
            st_row_bf16(OB + (size_t)(m + j) * DM, lane, o); }
    }
}
PHASE_FN phase_outproj(int L_, int wave_arg, int dry_) { const int L = __builtin_amdgcn_readfirstlane(L_), dry = __builtin_amdgcn_readfirstlane(dry_); PHASE_LOCALS

            pg8::StaticOrder S; S.init(OB, WOUT + (size_t)L * DM * DM, NTOK, DM, G, blk);
            pg8::EpiOut E{L == 0 ? x_in : nullptr, XB16, dry ? QB : XB16, modL + 2 * DM, SSL};
            pg8::gemm_phase<pg8::EpiOut, pg8::StaticOrder, false>(lds, wave, S, E);
        }
__device__ __forceinline__ void split_bf16(const f32x4& a, const f32x4& b, bf16x8& hi, bf16x8& lo) {
    u32x4 h; h.x = pk2(a[0], a[1]); h.y = pk2(a[2], a[3]); h.z = pk2(b[0], b[1]); h.w = pk2(b[2], b[3]);
    u32x4 l; l.x = pk2(a[0] - bf_lo(h.x), a[1] - bf_hi(h.x)); l.y = pk2(a[2] - bf_lo(h.y), a[3] - bf_hi(h.y)); l.z = pk2(b[0] - bf_lo(h.z), b[1] - bf_hi(h.z)); l.w = pk2(b[2] - bf_lo(h.w), b[3] - bf_hi(h.w));
    hi = __builtin_bit_cast(bf16x8, h); lo = __builtin_bit_cast(bf16x8, l);
}
PHASE_FN phase_route(int L_, int wave_arg, int dry_ = 0) { const int L = __builtin_amdgcn_readfirstlane(L_); const bool dry = __builtin_amdgcn_readfirstlane(dry_) != 0; PHASE_LOCALS
    if (!EPI_CONV && MOE_FP8 && !dry && L >= 1) conv_deferred(KA(), ctl, L, 1 << 20, wave, lane, (volatile LAS int*)(lds + MISC_OFF + MO_Q + 4));
    constexpr int HS = DM + 4;
    LAS float* hbuf = (LAS float*)lds;
    LAS float* part = (LAS float*)(lds + 69632);
    volatile LAS int* ent = misc + (MO_ENT / 4); volatile LAS int* hist = misc + (MO_HIST / 4); volatile LAS int* basep = misc + (MO_BASE / 4);
    const int e32 = lane & 31, kh = lane >> 5;
    const int mi = lane & 15, kk4 = lane >> 4, k0 = 128 * wave + 32 * kk4;
    bf16x8 wh[2][4], wl[2][4];
#pragma unroll
    for (int x = 0; x < 2; ++x) { const f32x4* wp = (const f32x4*)(WRT + ((size_t)L * NE + 16 * x + mi) * DM + k0);
#pragma unroll
      for (int j = 0; j < 4; ++j) { const f32x4 w0 = wp[2 * j], w1 = wp[2 * j + 1]; split_bf16(w0, w1, wh[x][j], wl[x][j]); } }
    const float brt = b_router[(size_t)L * NE + e32];
    for (int chunk = blk; chunk < NTOK / 128; chunk += G) {
        if (tid < NE) hist[tid] = 0;
        Row16 GS2, SH2; { const int b = (chunk * 128) >> 11; const float* modb = modL + (size_t)b * (NMOD * DM); ld_gs_sh(g_ffn + (size_t)L * DM, modb + 3 * DM, modb + 4 * DM, lane, GS2, SH2); }
        Row16 xna, xnb;
        { const int m0_ = chunk * 128 + 2 * wave; xna = ld_row_bf16(XB16 + (size_t)m0_ * DM, lane); xnb = ld_row_bf16(XB16 + (size_t)(m0_ + 1) * DM, lane); }
#pragma unroll 1
        for (int sub = 0; sub < 8; ++sub) {
            { const int ma = chunk * 128 + 16 * sub + 2 * wave;
              const Row16 xa = xna, xb = xnb;
              if (sub + 1 < 8) { xna = ld_row_bf16(XB16 + (size_t)(ma + 16) * DM, lane); xnb = ld_row_bf16(XB16 + (size_t)(ma + 17) * DM, lane); }
              const Row16 hq[2] = {norm_pre(xa, GS2, SH2), norm_pre(xb, GS2, SH2)};
#pragma unroll
              for (int j = 0; j < 2; ++j) { const Row16& h = hq[j]; const int rl = 2 * wave + j, m = ma + j;
                if (!MOE_FP8) st_row_bf16((bf16_t*)HB8 + (size_t)m * DM, lane, h); else
                { u32x2 a, c; a.x = pk4_fp8(h.v[0], h.v[1], h.v[2], h.v[3]); a.y = pk4_fp8(h.v[4], h.v[5], h.v[6], h.v[7]); c.x = pk4_fp8(h.v[8], h.v[9], h.v[10], h.v[11]); c.y = pk4_fp8(h.v[12], h.v[13], h.v[14], h.v[15]);
                  unsigned char* hp8 = HB8 + (size_t)m * DM; *(u32x2*)(hp8 + 8 * lane) = a; *(u32x2*)(hp8 + 512 + 8 * lane) = c; }
                LAS float* hr = hbuf + rl * HS;
                *(LAS f32x4*)(hr + 8 * lane) = (f32x4){h.v[0], h.v[1], h.v[2], h.v[3]}; *(LAS f32x4*)(hr + 8 * lane + 4) = (f32x4){h.v[4], h.v[5], h.v[6], h.v[7]};
                *(LAS f32x4*)(hr + 512 + 8 * lane) = (f32x4){h.v[8], h.v[9], h.v[10], h.v[11]}; *(LAS f32x4*)(hr + 516 + 8 * lane) = (f32x4){h.v[12], h.v[13], h.v[14], h.v[15]}; } }
            asm volatile("s_waitcnt lgkmcnt(0)\n\ts_barrier" ::: "memory");
            { f32x4 c0 = (f32x4){0.f, 0.f, 0.f, 0.f}, c1 = c0; const LAS f32x4* hp = (const LAS f32x4*)(hbuf + mi * HS + k0);
#pragma unroll
              for (int j = 0; j < 4; ++j) { const f32x4 h0 = hp[2 * j], h1 = hp[2 * j + 1]; bf16x8 ah, al; split_bf16(h0, h1, ah, al);
                  c0 = __builtin_amdgcn_mfma_f32_16x16x32_bf16(ah, wh[0][j], c0, 0, 0, 0); c1 = __builtin_amdgcn_mfma_f32_16x16x32_bf16(ah, wh[1][j], c1, 0, 0, 0);
                  c0 = __builtin_amdgcn_mfma_f32_16x16x32_bf16(ah, wl[0][j], c0, 0, 0, 0); c1 = __builtin_amdgcn_mfma_f32_16x16x32_bf16(ah, wl[1][j], c1, 0, 0, 0);
                  c0 = __builtin_amdgcn_mfma_f32_16x16x32_bf16(al, wh[0][j], c0, 0, 0, 0); c1 = __builtin_amdgcn_mfma_f32_16x16x32_bf16(al, wh[1][j], c1, 0, 0, 0); }
#pragma unroll
              for (int r = 0; r < 4; ++r) { part[((4 * kk4 + r) * 8 + wave) * 32 + mi] = c0[r]; part[((4 * kk4 + r) * 8 + wave) * 32 + 16 + mi] = c1[r]; } }
            asm volatile("s_waitcnt lgkmcnt(0)\n\ts_barrier" ::: "memory");
            { const int rl = 2 * wave + kh, rowl = 16 * sub + rl, m = chunk * 128 + rowl; float v = brt;
#pragma unroll
              for (int w = 0; w < 8; ++w) v += part[(rl * 8 + w) * 32 + e32];
              float tv[4]; int te[4];
#pragma unroll
              for (int k = 0; k < 4; ++k) { const float mx = half_max(v);
                  const unsigned long long bl = __ballot(v == mx); const unsigned mine = (unsigned)(bl >> (32 * kh)); const int ln = __builtin_ctz(mine);
                  tv[k] = mx; te[k] = ln; if (e32 == ln) v = -INFINITY; }
              const float e1 = fexp2((tv[1] - tv[0]) * LOG2E), e2 = fexp2((tv[2] - tv[0]) * LOG2E), e3 = fexp2((tv[3] - tv[0]) * LOG2E), isum = frcp(1.0f + e1 + e2 + e3);
              if (e32 < 4) { const float gk = (e32 == 0 ? 1.0f : (e32 == 1 ? e1 : (e32 == 2 ? e2 : e3))) * isum; const int ek = e32 == 0 ? te[0] : (e32 == 1 ? te[1] : (e32 == 2 ? te[2] : te[3]));
                  TOPG[(size_t)m * 4 + e32] = gk; ent[rowl * 4 + e32] = ek; } }
            asm volatile("s_waitcnt lgkmcnt(0)\n\ts_barrier" ::: "memory");
        }
        if (dry) { __syncthreads(); continue; }
        const int ek = ent[tid]; const int lr = atomicAdd((int*)(hist + ek), 1);
        __syncthreads();
        if (tid < NE) basep[tid] = (int)__hip_atomic_fetch_add(ctl + CW_GCNT + 64 * L + tid, (unsigned)hist[tid], __ATOMIC_RELAXED, __HIP_MEMORY_SCOPE_AGENT);
        __syncthreads();
        LIST[(size_t)ek * NTOK + basep[ek] + lr] = (chunk * 128 + (tid >> 2)) * 4 + (tid & 3);
        if (SLOT_OUT) POSE[(size_t)(chunk * 128) * 4 + tid] = (ek << 16) | (basep[ek] + lr);
        __syncthreads();
    }
}
PHASE_FN phase_gemm1(int L_, int wave_arg, int dry_ = 0) { const int L = __builtin_amdgcn_readfirstlane(L_); const bool dry = __builtin_amdgcn_readfirstlane(dry_) != 0; PHASE_LOCALS

            volatile LAS int* pre = misc + (MO_PRE / 4); volatile LAS int* cntl = misc + (MO_CNT / 4);
            expert_prefix(misc, ctl, L, tid); (void)cntl;
            __syncthreads();
            { volatile LAS int* t2e = misc + (MO_T2E / 4);
              for (int M = tid; M < 576; M += NTHREADS) { int e = 0;
#pragma unroll 1
                  for (int k = 1; k < NE; ++k) e += (M >= pre[k]) ? 1 : 0;
                  t2e[M] = e; } }
            __syncthreads();

            pg8::MoeOrder<8, true> S; S.MT = misc[(MO_PRE / 4) + NE]; S.G = G; S.c = blk; S.L = L; S.pre = (const LAS int*)(lds + MISC_OFF + MO_PRE);
            pg8::EpiGU E{L};
            pg8::gemm_phase<pg8::EpiGU, pg8::MoeOrder<8, true>, true, MOE_FP8 != 0>(lds, wave, S, E, dry);
            if (!EPI_CONV && MOE_FP8 && !dry && L + 1 < DEPTH && G == 256) {
                const int tot = S.MT * 8; pg8::Unit tu;
                if ((tot & 255) != 0 && !S.next(tot >> 8, tu)) conv_deferred(KA(), (gu32*)(KA()->ws + WS_CTL), L + 1, 2, wave, lane_id(), (volatile LAS int*)(lds + MISC_OFF + MO_Q + 4));
            }
        }
PHASE_FN phase_gemm2(int L_, int wave_arg, int dry_ = 0) { const int L = __builtin_amdgcn_readfirstlane(L_); const bool dry = __builtin_amdgcn_readfirstlane(dry_) != 0; PHASE_LOCALS

            volatile LAS int* pre = misc + (MO_PRE / 4); volatile LAS int* cntl = misc + (MO_CNT / 4);
            expert_prefix(misc, ctl, L, tid); (void)cntl;
            __syncthreads();
            { volatile LAS int* t2e = misc + (MO_T2E / 4);
              for (int M = tid; M < 576; M += NTHREADS) { int e = 0;
#pragma unroll 1
                  for (int k = 1; k < NE; ++k) e += (M >= pre[k]) ? 1 : 0;
                  t2e[M] = e; } }
            __syncthreads();

            pg8::MoeOrder<4, false> S; S.MT = misc[(MO_PRE / 4) + NE]; S.G = G; S.c = blk; S.L = L; S.pre = (const LAS int*)(lds + MISC_OFF + MO_PRE);
            pg8::EpiDN E{L};
            pg8::gemm_phase<pg8::EpiDN, pg8::MoeOrder<4, false>, false, MOE_FP8 != 0>(lds, wave, S, E, dry);
            if (!EPI_CONV && MOE_FP8 && !dry && L + 1 < DEPTH && G == 256) {
                const int tot = S.MT * 4; pg8::Unit tu;
                if ((tot & 255) != 0 && !S.next(tot >> 8, tu)) conv_deferred(KA(), (gu32*)(KA()->ws + WS_CTL), L + 1, 2, wave, lane_id(), (volatile LAS int*)(lds + MISC_OFF + MO_Q + 4));
            }
        }
PHASE_FN phase_combine(int L_, int wave_arg, int dry_ = 0) { const int L = __builtin_amdgcn_readfirstlane(L_); const bool dry = __builtin_amdgcn_readfirstlane(dry_) != 0; PHASE_LOCALS
    bf16_t* xdst16 = dry ? QB : XB16; float* xfin = dry ? (float*)KB : xres;
    LAS float* wf = (LAS float*)lds;
    volatile LAS int* pre = misc + (MO_PRE / 4);
    if (SLOT_OUT) expert_prefix(misc, ctl, L, tid);
    if (L + 1 < DEPTH) stage_wf(wf, w_in + (size_t)(L + 1) * DM * NIN, tid);
    __syncthreads();
    const int RPW = NTOK / NGW;
    if (RPW * NGW == NTOK && (RPW & 1) == 0 && (SEQ % RPW) == 0) {
        const int m0 = gw * RPW, b = m0 >> 11; const float* modb = modL + (size_t)b * (NMOD * DM);
        const Row16 GA = ld_row_f32(modb + 5 * DM, lane);
        Row16 GS, SH;
        if (L + 1 < DEPTH) { const float* modn = MOD + ((size_t)(L + 1) * NB + b) * (NMOD * DM); ld_gs_sh(g_attn + (size_t)(L + 1) * DM, modn, modn + DM, lane, GS, SH); }
        else { GS = ld_row_f32(g_final, lane);
#pragma unroll
            for (int i = 0; i < 16; ++i) SH.v[i] = 0.f; }
        for (int m = m0; m < m0 + RPW; m += 2) {
            Row16 xa = ld_row_bf16(XB16 + (size_t)m * DM, lane), xb = ld_row_bf16(XB16 + (size_t)(m + 1) * DM, lane);
            Row16 sa, sb;
#pragma unroll
            for (int i = 0; i < 16; ++i) { sa.v[i] = 0.f; sb.v[i] = 0.f; }
            if (OUT_FP8 && SLOT_OUT) { Raw8f ya[4], yb[4]; const unsigned char* ob8 = (const unsigned char*)OUTB;
                const u32x4 pa = *(const u32x4*)(POSE + (size_t)m * 4), pb = *(const u32x4*)(POSE + (size_t)(m + 1) * 4); const f32x4 ga4 = *(const f32x4*)(TOPG + (size_t)m * 4), gb4 = *(const f32x4*)(TOPG + (size_t)(m + 1) * 4);
#pragma unroll
                for (int k = 0; k < 4; ++k) { const unsigned ea = pa[k], eb = pb[k];
                    const size_t ra = (size_t)pre[ea >> 16] * 256 + (ea & 0xffffu), rb = (size_t)pre[eb >> 16] * 256 + (eb & 0xffffu);
                    ya[k] = ld_raw_fp8(ob8 + ra * DM, lane); yb[k] = ld_raw_fp8(ob8 + rb * DM, lane); }
#pragma unroll
                for (int k = 0; k < 4; ++k) { Row16 ta, tb;
#pragma unroll
                    for (int i = 0; i < 16; ++i) { ta.v[i] = 0.f; tb.v[i] = 0.f; }
                    acc_raw8(ta, ya[k]); acc_raw8(tb, yb[k]); const float wa = ga4[k] * (1.0f / 16.0f), wb = gb4[k] * (1.0f / 16.0f);
#pragma unroll
                    for (int i = 0; i < 16; ++i) { sa.v[i] += wa * ta.v[i]; sb.v[i] += wb * tb.v[i]; } }
            } else if (OUT_FP8) { Raw8f ya[4], yb[4]; const unsigned char* ob8 = (const unsigned char*)OUTB;
#pragma unroll
                for (int k = 0; k < 4; ++k) { ya[k] = ld_raw_fp8(ob8 + ((size_t)m * 4 + k) * DM, lane); yb[k] = ld_raw_fp8(ob8 + ((size_t)(m + 1) * 4 + k) * DM, lane); }
#pragma unroll
                for (int k = 0; k < 4; ++k) { acc_raw8(sa, ya[k]); acc_raw8(sb, yb[k]); }
#pragma unroll
                for (int i = 0; i < 16; ++i) { sa.v[i] *= (1.0f / 16.0f); sb.v[i] *= (1.0f / 16.0f); }
            } else { Raw8 ya[4], yb[4];
#pragma unroll
                for (int k = 0; k < 4; ++k) { ya[k] = ld_raw_bf16(OUTB + ((size_t)m * 4 + k) * DM, lane); yb[k] = ld_raw_bf16(OUTB + ((size_t)(m + 1) * 4 + k) * DM, lane); }
#pragma unroll
                for (int k = 0; k < 4; ++k) { acc_raw(sa, ya[k]); acc_raw(sb, yb[k]); } }
#pragma unroll
            for (int i = 0; i < 16; ++i) { xa.v[i] += GA.v[i] * sa.v[i]; xb.v[i] += GA.v[i] * sb.v[i]; }
            const Row16 ha = norm_pre(xa, GS, SH), hb = norm_pre(xb, GS, SH);
            if (L + 1 < DEPTH) {
                st_row_bf16(xdst16 + (size_t)m * DM, lane, xa); st_row_bf16(xdst16 + (size_t)(m + 1) * DM, lane, xb);
                st_row_h1(HB, HB8, (size_t)m, lane, ha); st_row_h1(HB, HB8, (size_t)(m + 1), lane, hb);
                forget_logits(ha, wf, b_forget + (size_t)(L + 1) * 6, LF2, b, m & (SEQ - 1), lane); forget_logits(hb, wf, b_forget + (size_t)(L + 1) * 6, LF2, b, (m + 1) & (SEQ - 1), lane);
            } else { st_row_f32(xfin + (size_t)m * DM, lane, ha); st_row_f32(xfin + (size_t)(m + 1) * DM, lane, hb); }
        }
    } else {
        for (int m = gw; m < NTOK; m += NGW) { const int b = m >> 11, t = m & (SEQ - 1); const float* modb = modL + (size_t)b * (NMOD * DM);
            Row16 x = ld_row_bf16(XB16 + (size_t)m * DM, lane);
            Row16 sy;
#pragma unroll
            for (int i = 0; i < 16; ++i) sy.v[i] = 0.f;
#pragma unroll
            for (int k = 0; k < 4; ++k) {
                if (OUT_FP8 && SLOT_OUT) { const unsigned ep = (unsigned)POSE[(size_t)m * 4 + k]; const size_t rr = (size_t)pre[ep >> 16] * 256 + (ep & 0xffffu); Row16 tt;
#pragma unroll
                    for (int i = 0; i < 16; ++i) tt.v[i] = 0.f;
                    acc_raw8(tt, ld_raw_fp8((const unsigned char*)OUTB + rr * DM, lane)); const float wk = TOPG[(size_t)m * 4 + k];
#pragma unroll
                    for (int i = 0; i < 16; ++i) sy.v[i] += wk * tt.v[i]; }
                else if (OUT_FP8) acc_raw8(sy, ld_raw_fp8((const unsigned char*)OUTB + ((size_t)m * 4 + k) * DM, lane)); else acc_raw(sy, ld_raw_bf16(OUTB + ((size_t)m * 4 + k) * DM, lane)); }
            const Row16 ga = ld_row_f32(modb + 5 * DM, lane);
#pragma unroll
            for (int i = 0; i < 16; ++i) x.v[i] += ga.v[i] * sy.v[i] * (OUT_FP8 ? (1.0f / 16.0f) : 1.0f);
            if (L + 1 < DEPTH) { st_row_bf16(xdst16 + (size_t)m * DM, lane, x);
                const float* modn = MOD + ((size_t)(L + 1) * NB + b) * (NMOD * DM);
                const Row16 h = norm_mod(x, g_attn + (size_t)(L + 1) * DM, modn, modn + DM, lane);
                st_row_h1(HB, HB8, (size_t)m, lane, h); forget_logits(h, wf, b_forget + (size_t)(L + 1) * 6, LF2, b, t, lane);
            } else { float ss = 0.f;
#pragma unroll
                for (int i = 0; i < 16; ++i) ss += x.v[i] * x.v[i];
                const float rinv = frsq(wave_sum(ss) * (1.0f / DM) + EPS); const Row16 gf = ld_row_f32(g_final, lane);
#pragma unroll
                for (int i = 0; i < 16; ++i) x.v[i] = x.v[i] * rinv * gf.v[i];
                st_row_f32(xfin + (size_t)m * DM, lane, x); }
        }
    }
    __syncthreads();
}

__global__ void __launch_bounds__(NTHREADS, 2) hybrid_fwd(Args args) {
    LAS unsigned char* lds = (LAS unsigned char*)lds_raw;
    const int wv = __builtin_amdgcn_readfirstlane((int)threadIdx.x >> 6);
    for (int u = threadIdx.x; u < (LDS_BYTES - MISC_OFF) / 4; u += NTHREADS) ((LAS unsigned*)(lds + MISC_OFF))[u] = 0u;
    __syncthreads();
    unsigned* barw = (unsigned*)(args.ws + WS_CTL) + CW_BAR;
    XcdBarrier bar; bar.bar = barw; bar.x = 0; bar.st = nullptr; bar.wave = wv;
    if (N_LAUNCHES == 1) bar = xcd_barrier_post(barw, (volatile LAS unsigned*)(lds + MISC_OFF + MO_BAR));
    bar.wave = wv;
    const int lo = args.ph_lo, hi = args.ph_hi;
#define IN(k) (lo <= (k) && (k) < hi)
#define SEAM(k) do { if (IN(k) && IN((k) + 1)) xcd_barrier(bar); } while (0)
    if (EN(0) && IN(0)) { phase_prologue(wv); for (int r = 0; r < REP_PRO; ++r) phase_prologue(wv); }
    SEAM(0);
    if (EN(1) && IN(1)) phase_norm0(wv);
    SEAM(1);
    for (int L = 0; L < DEPTH; ++L) {
        const int P = 2 + 8 * L;
        if (EN(2) && IN(P + 0)) { phase_qkv(L, wv); for (int r = 0; r < REP_QKV; ++r) phase_qkv(L, wv); for (int r = 0; r < REP_DRYQKV; ++r) phase_qkv(L, wv, 1); }
        SEAM(P + 0);
        if (EN(3) && IN(P + 1)) { phase_attn(L, 0, wv); for (int r = 0; r < REP_ATT; ++r) phase_attn(L, 1 + r, wv); }
        SEAM(P + 1);
        if (!FUSE_ONORM) { if (EN(4) && IN(P + 2)) { phase_onorm(L, wv); for (int r = 0; r < REP_ONORM; ++r) phase_onorm(L, wv); }
        SEAM(P + 2); }
        if (EN(5) && IN(P + 3)) { for (int r = 0; r < REP_OUT; ++r) phase_outproj(L, wv, 1); phase_outproj(L, wv, 0); }
        SEAM(P + 3);
        if (EN(6) && IN(P + 4)) { for (int r = 0; r < REP_ROUTE; ++r) phase_route(L, wv, 1); phase_route(L, wv); }
        SEAM(P + 4);
        if (EN(7) && IN(P + 5)) { phase_gemm1(L, wv); for (int r = 0; r < REP_G1; ++r) phase_gemm1(L, wv); for (int r = 0; r < REP_DRYG1; ++r) phase_gemm1(L, wv, 1); }
        SEAM(P + 5);
        if (EN(8) && IN(P + 6)) { phase_gemm2(L, wv); for (int r = 0; r < REP_G2; ++r) phase_gemm2(L, wv); for (int r = 0; r < REP_DRYG2; ++r) phase_gemm2(L, wv, 1); }
        SEAM(P + 6);
        if (EN(9) && IN(P + 7)) { for (int r = 0; r < REP_COMB; ++r) phase_combine(L, wv, 1); phase_combine(L, wv); }
        SEAM(P + 7);
    }
#undef IN
#undef SEAM
}


#if N_LAUNCHES == 0 && defined(DBG_CHK)
constexpr size_t WS_CHKPREV = 1700 * MiB;
constexpr int CW_CHK = 32768;
__global__ void chk_kernel(const unsigned* p, size_t nwords, unsigned* acc) {
    unsigned s = 0; for (size_t i = (size_t)blockIdx.x * blockDim.x + threadIdx.x; i < nwords; i += (size_t)gridDim.x * blockDim.x) s += p[i] * 2654435761u + (unsigned)(i & 0xffff) * p[i];
    for (int o = 1; o < 64; o <<= 1) s += __shfl_xor(s, o);
    if ((threadIdx.x & 63) == 0) atomicAdd(acc, s);
}
__global__ void chk_list_kernel(const int* list, const unsigned* gcnt, unsigned* acc) {
    const int e = blockIdx.x; const unsigned n = gcnt[e]; unsigned s = n * 977u;
    for (unsigned i = threadIdx.x; i < n; i += blockDim.x) { const unsigned v = (unsigned)list[(size_t)e * NTOK + i]; s += v * 2654435761u + (v >> 7); }
    for (int o = 1; o < 64; o <<= 1) s += __shfl_xor(s, o);
    if ((threadIdx.x & 63) == 0) atomicAdd(acc, s);
}
__global__ void chk_fin(unsigned* cur, unsigned* prev, float* scale, int n) {
    int first = -1; for (int k = 0; k < n; ++k) { if (prev[k] != 0xAAAAAAAAu && prev[k] != cur[k] && first < 0) first = k; }
    for (int k = 0; k < n; ++k) prev[k] = cur[k];
    float sc = 1.0f; if (first >= 0) { sc = 1.6f; for (int k = 0; k < first; ++k) sc = 1.0f + (sc - 1.0f) * 0.6f; }
    *scale = sc;
}
__global__ void chk_scale(float* out, size_t n, const float* scale) { const float sc = *scale; for (size_t i = (size_t)blockIdx.x * blockDim.x + threadIdx.x; i < n; i += (size_t)gridDim.x * blockDim.x) out[i] *= sc; }
#endif

extern "C" void kernel_launch(void* const* d_in, const int* in_sizes, int n_in, void* d_out, int out_size, void* d_ws, size_t ws_size, hipStream_t stream) {
    static int grid = 0;
    if (grid == 0) {
        if (n_in != 18 || out_size != NTOK * DM || ws_size < WS_END) { fprintf(stderr, "kernel_launch: unexpected shapes (n_in %d, out %d, ws %zu)\n", n_in, out_size, ws_size); grid = -1; return; }
        int dev = 0, cus = 0, per_cu = 0;
        if (hipGetDevice(&dev) != hipSuccess || hipDeviceGetAttribute(&cus, hipDeviceAttributeMultiprocessorCount, dev) != hipSuccess) { grid = -1; return; }
        if (hipFuncSetAttribute((const void*)hybrid_fwd, hipFuncAttributeMaxDynamicSharedMemorySize, LDS_BYTES) != hipSuccess) { fprintf(stderr, "kernel_launch: hipFuncSetAttribute failed\n"); grid = -1; return; }
        if (hipOccupancyMaxActiveBlocksPerMultiprocessor(&per_cu, (const void*)hybrid_fwd, NTHREADS, LDS_BYTES) != hipSuccess || per_cu < 1) fprintf(stderr, "kernel_launch: occupancy query reports %d\n", per_cu);
        (void)hipGetLastError();
        grid = cus;
    }
    if (grid < 0) return;
    if (hipMemsetAsync((char*)d_ws + WS_CTL, 0, CTL_ZERO_BYTES, stream) != hipSuccess) return;
    Args a{};
    for (int i = 0; i < 18; ++i) a.in[i] = (const float*)d_in[i];
    a.out = (float*)d_out; a.ws = (unsigned char*)d_ws;
#if N_LAUNCHES == 1
    a.ph_lo = 0; a.ph_hi = N_PHASES;
    hipLaunchKernelGGL(hybrid_fwd, dim3(grid), dim3(NTHREADS), LDS_BYTES, stream, a);
#else
    for (int p = 0; p < N_PHASES; ++p) { a.ph_lo = p; a.ph_hi = p + 1; hipLaunchKernelGGL(hybrid_fwd, dim3(grid), dim3(NTHREADS), LDS_BYTES, stream, a);
#if defined(DBG_CHK)
        unsigned char* w = (unsigned char*)d_ws; unsigned* cur = (unsigned*)(w + WS_CTL) + CW_CHK;
#define CHK(k, off, bytes) hipLaunchKernelGGL(chk_kernel, dim3(1024), dim3(256), 0, stream, (const unsigned*)(w + (off)), (size_t)(bytes) / 4, cur + (k))
        if (p == 2) { CHK(0, WS_MOD, 4 * MiB); CHK(0, WS_ROPE, 8 * MiB); CHK(0, WS_WIN, 800 * MiB); CHK(0, WS_WRT, 512 * 1024); CHK(0, WS_LF2, 768 * 1024); CHK(0, WS_Q, 192 * MiB); }
        if (p == 3) { CHK(1, WS_O, 64 * MiB); }
        if (p == 5) { hipLaunchKernelGGL(chk_kernel, dim3(1024), dim3(256), 0, stream, (const unsigned*)d_out, (size_t)NTOK * DM, cur + 2); }
        if (p == 6) { CHK(3, WS_H, 64 * MiB); CHK(3, WS_TOPG, 512 * 1024); hipLaunchKernelGGL(chk_list_kernel, dim3(32), dim3(256), 0, stream, (const int*)(w + WS_LIST), (const unsigned*)(w + WS_CTL) + CW_GCNT, cur + 3); }
        if (p == 8) { CHK(4, WS_OUTB, 256 * MiB); }
        if (p == 9) { hipLaunchKernelGGL(chk_kernel, dim3(1024), dim3(256), 0, stream, (const unsigned*)d_out, (size_t)NTOK * DM, cur + 5); }
#endif
    }
#if defined(DBG_CHK)
    { unsigned char* w = (unsigned char*)d_ws; unsigned* cur = (unsigned*)(w + WS_CTL) + CW_CHK;
      hipLaunchKernelGGL(chk_fin, dim3(1), dim3(1), 0, stream, cur, (unsigned*)(w + WS_CHKPREV), (float*)(cur + 64), 6);
      hipLaunchKernelGGL(chk_scale, dim3(1024), dim3(256), 0, stream, (float*)d_out, (size_t)NTOK * DM, (const float*)(cur + 64)); }
#endif
#endif
}
```

```cpp
#include <hip/hip_runtime.h>
#include <cstdio>
#include <cstdint>
#include <cmath>

#ifndef N_LAUNCHES
#define N_LAUNCHES 1
#endif
#ifndef PH_MASK
#define PH_MASK 0xFFFF
#endif
#define EN(k) ((PH_MASK >> (k)) & 1)
#ifndef ATT_MASK
#define ATT_MASK 7
#endif
#ifndef MOE_FP8
#define MOE_FP8 1
#endif
#ifndef X16
#define X16 1
#endif
#ifndef SLOT_OUT
#define SLOT_OUT 1
#endif
#ifndef FUSE_ONORM
#define FUSE_ONORM 1
#endif
#ifndef QKV_FP8
#define QKV_FP8 2
#endif
#ifndef OUT_FP8
#define OUT_FP8 1
#endif
#ifndef REP_DRYQKV
#define REP_DRYQKV 0
#endif
#ifndef REP_DRYG1
#define REP_DRYG1 0
#endif
#ifndef REP_DRYG2
#define REP_DRYG2 0
#endif
#ifndef REP_ONORM
#define REP_ONORM 0
#endif
#ifndef REP_OUT
#define REP_OUT 0
#endif
#ifndef REP_COMB
#define REP_COMB 0
#endif
#ifndef REP_ROUTE
#define REP_ROUTE 0
#endif
#ifndef REP_ATT_MASK
#define REP_ATT_MASK 7
#endif
#ifndef REP_ATT
#define REP_ATT 0
#endif
#ifndef REP_QKV
#define REP_QKV 0
#endif
#ifndef REP_G1
#define REP_G1 0
#endif
#ifndef REP_G2
#define REP_G2 0
#endif
#ifndef REP_PRO
#define REP_PRO 0
#endif

#define LAS __attribute__((address_space(3)))
#define GAS __attribute__((address_space(1)))
typedef unsigned short bf16_t;
typedef short bf16x8 __attribute__((ext_vector_type(8)));
typedef short s16x4 __attribute__((ext_vector_type(4)));
typedef float f32x2 __attribute__((ext_vector_type(2)));
typedef float f32x4 __attribute__((ext_vector_type(4)));
typedef float f32x4u __attribute__((ext_vector_type(4), aligned(4)));
typedef float f32x16 __attribute__((ext_vector_type(16)));
typedef unsigned u32x2 __attribute__((ext_vector_type(2)));
typedef unsigned u32x4 __attribute__((ext_vector_type(4)));
typedef int v8i32 __attribute__((ext_vector_type(8)));
typedef __bf16 bf16x2_t __attribute__((ext_vector_type(2)));
typedef GAS unsigned gu32;

constexpr int DM = 1024, NB = 16, SEQ = 2048, NTOK = NB * SEQ, DEPTH = 4, NIN = 3078, NE = 32, NMOD = 6;
constexpr float LOG2E = 1.4426950408889634f;
constexpr float QSCALE = 0.125f * LOG2E;
constexpr float EPS = 1e-6f;
constexpr int NWAVES = 8, NTHREADS = 512;

constexpr size_t MiB = 1u << 20;
constexpr size_t WS_CTL = 0, CTL_ZERO_BYTES = 1 * MiB;
constexpr size_t WS_SS = 2 * MiB;
constexpr size_t WS_MOD = 4 * MiB;
constexpr size_t WS_ROPE = 8 * MiB;
constexpr size_t WS_LF2 = 16 * MiB;
constexpr size_t WS_TOPG = 17 * MiB;
constexpr size_t WS_WRT = 18 * MiB;
constexpr size_t WS_LIST = 20 * MiB;
constexpr size_t WS_POSE = 24 * MiB;
constexpr size_t WS_WIN = 32 * MiB;
constexpr size_t WS_WOUT = 56 * MiB;
constexpr size_t WS_WGU = 64 * MiB;
constexpr size_t WS_WDN = 576 * MiB;
constexpr size_t WS_H = 832 * MiB;
constexpr size_t WS_Q = 896 * MiB, WS_K = 960 * MiB, WS_V = 1024 * MiB, WS_O = 1088 * MiB;
constexpr size_t WS_ACT = 1152 * MiB;
constexpr size_t WS_OUTB = 1424 * MiB;
constexpr size_t WS_H8 = 1680 * MiB;
constexpr size_t WS_WIN8 = 1744 * MiB;
constexpr size_t WS_X16 = 1760 * MiB;
constexpr size_t WS_END = 1824 * MiB;
constexpr int CW_BAR = 4096;
constexpr int CW_GCNT = 16384;
#ifndef EPI_CONV
#define EPI_CONV 1
#endif
constexpr int CW_CONV = 24576;
constexpr int CW_AQ = 20480;

constexpr int RING_BYTES = 131072;
constexpr int MISC_OFF = RING_BYTES;
constexpr int LDS_BYTES = 147456;
constexpr int MO_BAR = 0, MO_Q = 16, MO_VOTE = 64, MO_SCAN = 128, MO_PRE = 256, MO_CNT = 512, MO_HIST = 1024, MO_BASE = 1152, MO_ENT = 2048, MO_T2E = 4096, MO_RF = 8192;

__device__ __forceinline__ int lane_id() { int l; asm volatile("v_mbcnt_lo_u32_b32 %0, -1, 0\n\tv_mbcnt_hi_u32_b32 %0, -1, %0" : "=v"(l)); return l; }
#ifndef DBG_SHFL
#define DBG_SHFL 0
#endif
#define DPP_F(v, ctrl, rmask) __builtin_bit_cast(float, __builtin_amdgcn_update_dpp(0, __builtin_bit_cast(int, (float)(v)), (ctrl), (rmask), 0xf, true))
__device__ __forceinline__ float wave_sum(float v) {
    if (DBG_SHFL & 1) { for (int o = 1; o < 64; o <<= 1) v += __shfl_xor(v, o); return v; }
    v += DPP_F(v, 0xB1, 0xf); v += DPP_F(v, 0x4E, 0xf); v += DPP_F(v, 0x141, 0xf); v += DPP_F(v, 0x140, 0xf);
    v += DPP_F(v, 0x142, 0xa); v += DPP_F(v, 0x143, 0xc);
    return __builtin_bit_cast(float, __builtin_amdgcn_readlane(__builtin_bit_cast(int, v), 63));
}
#define DPP_FM(v, ctrl, rmask) __builtin_bit_cast(float, __builtin_amdgcn_update_dpp(__builtin_bit_cast(int, (float)(v)), __builtin_bit_cast(int, (float)(v)), (ctrl), (rmask), 0xf, false))
__device__ __forceinline__ float wave_max(float v) {
    v = fmaxf(v, DPP_FM(v, 0xB1, 0xf)); v = fmaxf(v, DPP_FM(v, 0x4E, 0xf)); v = fmaxf(v, DPP_FM(v, 0x141, 0xf)); v = fmaxf(v, DPP_FM(v, 0x140, 0xf));
    v = fmaxf(v, DPP_FM(v, 0x142, 0xa)); v = fmaxf(v, DPP_FM(v, 0x143, 0xc));
    return __builtin_bit_cast(float, __builtin_amdgcn_readlane(__builtin_bit_cast(int, v), 63));
}
__device__ __forceinline__ float half_max(float v) {
    if (DBG_SHFL & 2) { for (int o = 1; o < 32; o <<= 1) v = fmaxf(v, __shfl_xor(v, o)); return v; }
    v = fmaxf(v, DPP_FM(v, 0xB1, 0xf)); v = fmaxf(v, DPP_FM(v, 0x4E, 0xf)); v = fmaxf(v, DPP_FM(v, 0x141, 0xf)); v = fmaxf(v, DPP_FM(v, 0x140, 0xf));
    return fmaxf(v, __builtin_bit_cast(float, __builtin_amdgcn_ds_swizzle(__builtin_bit_cast(int, v), 0x401F)));
}
__device__ __forceinline__ float xhalf_get(float v, int lane) { return __builtin_bit_cast(float, __builtin_amdgcn_ds_bpermute((lane ^ 32) << 2, __builtin_bit_cast(int, v))); }
__device__ __forceinline__ float xhalf_sum(float v, int lane) { return v + xhalf_get(v, lane); }
__device__ __forceinline__ unsigned pk2(float lo, float hi) { f32x2 v = {lo, hi}; bf16x2_t b = __builtin_convertvector(v, bf16x2_t); return __builtin_bit_cast(unsigned, b); }
__device__ __forceinline__ unsigned pk4_fp8(float a, float b, float c, float d) { int p = __builtin_amdgcn_cvt_pk_fp8_f32(a, b, 0, false); p = __builtin_amdgcn_cvt_pk_fp8_f32(c, d, p, true); return (unsigned)p; }
__device__ __forceinline__ float bf_lo(unsigned u) { return __uint_as_float(u << 16); }
__device__ __forceinline__ float bf_hi(unsigned u) { return __uint_as_float(u & 0xffff0000u); }
__device__ __forceinline__ float fexp2(float x) { return __builtin_amdgcn_exp2f(x); }
__device__ __forceinline__ float flog2(float x) { return __builtin_amdgcn_logf(x); }
__device__ __forceinline__ float frcp(float x) { return __builtin_amdgcn_rcpf(x); }
__device__ __forceinline__ float frsq(float x) { return __builtin_amdgcn_rsqf(x); }

#define XB_TMO      128
#define XB_XCNT(j)  (256  + 64 * (j))
#define XB_XSUB(j)  (1280 + 64 * (j))
#define XB_XGEN(j)  (2304 + 64 * (j))
#define XB_TOP      3328
#define XB_TOPGEN   3392
#define XCD_BAR_WORDS 3456
#define XB_SPIN_CAP (1u << 22)
__device__ __forceinline__ unsigned xb_ld(unsigned* p)              { return __hip_atomic_load(p, __ATOMIC_RELAXED, __HIP_MEMORY_SCOPE_AGENT); }
__device__ __forceinline__ unsigned xb_add(unsigned* p, unsigned v) { return __hip_atomic_fetch_add(p, v, __ATOMIC_RELAXED, __HIP_MEMORY_SCOPE_AGENT); }
__device__ __forceinline__ unsigned xb_xcc_id() { return (unsigned)__builtin_amdgcn_s_getreg((3 << 11) | 20) & 0xFu; }
#define XB_SPIN(cond, bar) do { unsigned _sp = 0; while (cond) { __builtin_amdgcn_s_sleep(1); \
    if ((++_sp & 255u) == 0u) { if (xb_ld(&(bar)[XB_TMO])) break; if (_sp > XB_SPIN_CAP) { atomicAdd(&(bar)[XB_TMO], 1u); break; } } } } while (0)
struct XcdBarrier { unsigned* bar; unsigned x; volatile LAS unsigned* st; int wave; };
__device__ __forceinline__ XcdBarrier xcd_barrier_post(unsigned* bar, volatile LAS unsigned* st) {
    XcdBarrier b; b.bar = bar; b.x = xb_xcc_id(); b.st = st; b.wave = 0;
    if (threadIdx.x == 0) (void)xb_add(&bar[XB_XCNT(b.x)], 1u);
    return b;
}
__device__ __forceinline__ void xcd_barrier_complete(unsigned* bar, unsigned x, unsigned& nloc, unsigned& nx) {
    const unsigned G = gridDim.x * gridDim.y * gridDim.z;
    unsigned sum, cnt, mine, sp = 0u;
    for (;;) {
        sum = 0u; cnt = 0u; mine = 0u;
#pragma unroll
        for (unsigned j = 0; j < 16; ++j) { const unsigned c = xb_ld(&bar[XB_XCNT(j)]); sum += c; cnt += (c > 0u) ? 1u : 0u; }
        mine = xb_ld(&bar[XB_XCNT(x)]);
        if (sum == G) break;
        __builtin_amdgcn_s_sleep(1);
        if ((++sp & 255u) == 0u) { if (xb_ld(&bar[XB_TMO])) break; if (sp > XB_SPIN_CAP) { atomicAdd(&bar[XB_TMO], 1u); break; } }
    }
    nloc = mine > 0u ? mine : 1u; nx = cnt > 0u ? cnt : 1u;
}
__device__ __forceinline__ void xcd_barrier(const XcdBarrier& b) {
    asm volatile("s_waitcnt vmcnt(0)" ::: "memory");
    __syncthreads();
    if (b.wave == 0 && lane_id() == 0) {
        unsigned* bar = b.bar; asm volatile("" : "+s"(bar));
        __builtin_amdgcn_s_waitcnt(0);
        unsigned nloc = b.st[0], nx = b.st[1];
        if (nloc == 0u) { xcd_barrier_complete(bar, b.x, nloc, nx); b.st[0] = nloc; b.st[1] = nx; }
        const unsigned old = xb_add(&bar[XB_XSUB(b.x)], 1u);
        const unsigned gen = old / nloc;
        if (old + 1u == (gen + 1u) * nloc) {
            __builtin_amdgcn_fence(__ATOMIC_RELEASE, "agent");
            asm volatile("s_waitcnt vmcnt(0)" ::: "memory");
            const unsigned og = xb_add(&bar[XB_TOP], 1u);
            const unsigned tg = og / nx;
            if (og + 1u == (tg + 1u) * nx) xb_add(&bar[XB_TOPGEN], 1u);
            else XB_SPIN(xb_ld(&bar[XB_TOPGEN]) == tg, bar);
            __builtin_amdgcn_fence(__ATOMIC_ACQUIRE, "agent");
            xb_add(&bar[XB_XGEN(b.x)], 1u);
            asm volatile("s_waitcnt vmcnt(0)" ::: "memory");
        } else {
            XB_SPIN(xb_ld(&bar[XB_XGEN(b.x)]) == gen, bar);
            __builtin_amdgcn_fence(__ATOMIC_ACQUIRE, "agent");
            asm volatile("s_waitcnt vmcnt(0)" ::: "memory");
        }
    }
    __syncthreads();
}

struct Args { const float* in[18]; float* out; unsigned char* ws; int ph_lo, ph_hi; };
extern __shared__ __attribute__((aligned(16))) unsigned char lds_raw[];
typedef const __attribute__((address_space(4))) Args* kargs_t;
#define KA() ({ kargs_t _p = (kargs_t)__builtin_amdgcn_kernarg_segment_ptr(); asm volatile("" : "+s"(_p)); _p; })
#define WSP(T, off) ((T*)(ka->ws + (off)))
#define INF(k) (ka->in[k])

template <int MAP> __device__ __forceinline__ int wrow_map(int n);
namespace pg8 {
constexpr int BM = 256, BK = 64, HALF = 128, HTB = HALF * BK * 2, STAGE_BYTES = 8 * HTB, NXCD = 8, WGM = 8, KK = 1024;
__host__ __device__ __forceinline__ int lds_byte(int r, int c) { const int st = (r >> 4) * 2 + (c >> 5), rr = r & 15, cc = c & 31, ob = rr * 64 + cc * 2; return st * 1024 + (ob ^ (((ob >> 9) & 1) << 5)); }
__host__ __device__ __forceinline__ void stage_rc(int b, int& R, int& C) { const int st = b / 1024, sb = b % 1024, swz = sb ^ (((sb >> 9) & 1) << 5); R = (st >> 1) * 16 + swz / 64; C = (st & 1) * 32 + (swz % 64) / 2; }
__host__ __device__ __forceinline__ int perm32(int rho) { const int n = rho >> 4, i = rho & 15; return 8 * (i >> 2) + 4 * n + (i & 3); }

struct Unit { int pm, pn, e, nvalid, mt; const char* A; const char* B; };

template <int PITCH_>
struct StaticOrderT {
    static constexpr int PITCH = PITCH_;
    int nM, nN, nwg, G, c; const char* A; const char* Bt; unsigned long long pnmap;
    __device__ void init(const void* A_, const void* Bt_, int M, int N, int G_, int c_) { A = (const char*)A_; Bt = (const char*)Bt_; nM = M / BM; nN = N / BM; nwg = nM * nN; G = G_; c = c_; pnmap = 0xFEDCBA9876543210ull; }
    __device__ void restrict_cols(unsigned long long map, int count) { pnmap = map; nN = count; nwg = nM * nN; }
    __device__ bool next(int i, Unit& u) const {
        const long L = (long)i * G + c; if (L >= nwg) return false;
        int wgid = (int)L; { const int q = nwg / NXCD, r = nwg % NXCD, xcd = wgid % NXCD, off = wgid / NXCD; wgid = (xcd < r ? xcd * (q + 1) : r * (q + 1) + (xcd - r) * q) + off; }
        const int nig = WGM * nN, gid = wgid / nig, fm = gid * WGM, gsz = (nM - fm) < WGM ? (nM - fm) : WGM;
        u.pm = fm + ((wgid % nig) % gsz); u.pn = (int)((pnmap >> (4 * ((wgid % nig) / gsz))) & 15ull); u.e = 0; u.nvalid = 256; u.mt = 0;
        u.A = A + (size_t)u.pm * (BM * PITCH); u.B = Bt + (size_t)u.pn * (BM * PITCH); return true;
    }
    __device__ __forceinline__ unsigned row_off(const Unit&, int row) const { return (unsigned)row * PITCH; }
    __device__ __forceinline__ void row_off4(const Unit&, const int (&row)[4], unsigned (&off)[4]) const {
#pragma unroll
        for (int q = 0; q < 4; ++q) off[q] = (unsigned)row[q] * PITCH; }
    __device__ __forceinline__ void list_dma(LAS unsigned char*, const Unit&, int) const {}
    __device__ __forceinline__ void row_off4_lds(LAS unsigned char*, const Unit& u, const int (&row)[4], unsigned (&off)[4]) const { row_off4(u, row, off); }
};
typedef StaticOrderT<2 * KK> StaticOrder;

template <int NTL, bool GATHER>
struct MoeOrder {
    static constexpr int PITCH = MOE_FP8 ? KK : 2 * KK;
    int MT, G, c, L; const LAS int* pre;
    __device__ bool next(int i, Unit& u) const {
        const long Lu = (long)i * G + c; int M, nt;
        if (G == 256) { const int win = (int)(Lu >> 8), w = (int)(Lu & 255), x = w & 7, j = w >> 3;
            if (NTL == 8) { M = 32 * win + 4 * x + (j >> 3); nt = j & 7; } else { M = 64 * win + 8 * x + (j >> 2); nt = j & 3; } }
        else { M = (int)(Lu / NTL); nt = (int)(Lu % NTL); }
        if (M >= MT) return false;
        const LAS int* pp = pre; asm volatile("" : "+v"(pp));
        const int e = __builtin_amdgcn_readfirstlane(pp[(MO_T2E - MO_PRE) / 4 + M]);
        const int mt = M - __builtin_amdgcn_readfirstlane(pp[e]);
        u.pm = M; u.pn = nt; u.e = e; u.mt = mt; const int left = __builtin_amdgcn_readfirstlane(pp[(MO_CNT - MO_PRE) / 4 + e]) - 256 * mt; u.nvalid = left < 256 ? left : 256;
        kargs_t ka = KA();
        const char* W = (const char*)ka->ws + (NTL == 8 ? WS_WGU : WS_WDN) + ((size_t)L * NE + e) * ((size_t)(NTL == 8 ? 2048 : 1024) * PITCH);
        u.B = W + (size_t)nt * (BM * PITCH);
        u.A = GATHER ? (const char*)ka->ws + WS_H8 : (const char*)ka->ws + WS_ACT + (size_t)M * (BM * PITCH);
        return true;
    }
    __device__ __forceinline__ unsigned row_off(const Unit& u, int row) const {
        if (!GATHER) return (unsigned)row * PITCH;
        const int rr = row < u.nvalid ? row : 0;
        kargs_t ka = KA(); const int* list = (const int*)(ka->ws + WS_LIST);
        const int ent = list[(size_t)u.e * NTOK + (size_t)u.mt * 256 + rr];
        return (unsigned)(ent >> 2) * PITCH;
    }
    __device__ __forceinline__ void list_dma(LAS unsigned char* lds, const Unit& u, int wid) const {
        if (!GATHER) return;
        if (wid == 0) { kargs_t ka = KA(); const int* lp = (const int*)(ka->ws + WS_LIST) + (size_t)u.e * NTOK + (size_t)u.mt * 256 + 4 * lane_id();
            __builtin_amdgcn_global_load_lds((const unsigned*)lp, (LAS unsigned*)(lds + MISC_OFF + MO_RF), 16, 0, 0); }
    }
    __device__ __forceinline__ void row_off4_lds(LAS unsigned char* lds, const Unit& u, const int (&row)[4], unsigned (&off)[4]) const {
        const LAS int* ll = (const LAS int*)(lds + MISC_OFF + MO_RF);
        int ent[4];
#pragma unroll
        for (int q = 0; q < 4; ++q) ent[q] = GATHER ? ll[row[q] < u.nvalid ? row[q] : 0] : 0;
#pragma unroll
        for (int q = 0; q < 4; ++q) off[q] = GATHER ? (unsigned)(ent[q] >> 2) * PITCH : (unsigned)row[q] * PITCH;
    }
    __device__ __forceinline__ void row_off4(const Unit& u, const int (&row)[4], unsigned (&off)[4]) const {
        if (!GATHER) {
#pragma unroll
            for (int q = 0; q < 4; ++q) off[q] = (unsigned)row[q] * PITCH;
            return; }
        kargs_t ka = KA(); const int* lp = (const int*)(ka->ws + WS_LIST) + (size_t)u.e * NTOK + (size_t)u.mt * 256;
        int ent[4];
#pragma unroll
        for (int q = 0; q < 4; ++q) ent[q] = lp[row[q] < u.nvalid ? row[q] : 0];
#pragma unroll
        for (int q = 0; q < 4; ++q) off[q] = (unsigned)(ent[q] >> 2) * PITCH;
    }
};

__device__ __forceinline__ unsigned cvt_pk_bf16(float lo, float hi) { return pk2(lo, hi); }

template <class Epi, class Sched, bool DYN_A, bool FP8 = false>
__device__ __forceinline__ void gemm_phase(LAS unsigned char* lds, const int wid, const Sched& S, const Epi& E, const bool dry = false) {
    const int lane = lane_id(), tid = 64 * wid + lane, wr = wid >> 2, wc = wid & 3, fr = lane & 15, fq = lane >> 4;
    constexpr int PITCH = Sched::PITCH, nt = PITCH / 128;
    static_assert(PITCH == (FP8 ? KK : 2 * KK), "operand pitch vs element type");
    unsigned voffB[2];
#pragma unroll
    for (int i = 0; i < 2; ++i) { int R, C; stage_rc(tid * 16 + i * 8192, R, C); const int Rb = Epi::PERM ? ((R & ~31) + perm32(R & 31)) : R; voffB[i] = (unsigned)(Rb * PITCH + C * 2); }
    const size_t kstep = (size_t)(BK * 2);
    const size_t hstep = (size_t)HALF * PITCH;
    const unsigned ldsw = (unsigned)wid * 1024u;
    const int aoff = lds_byte(wr * 64 + fr, fq * 8), boff = lds_byte(wc * 32 + fr, fq * 8);
#define PG8_SA(b, h) (((b) * 2 + (h)) * HTB)
#define PG8_SB(b, h) ((4 + (b) * 2 + (h)) * HTB)
#define PG8_STAGE(bufoff, gbase, voff) do { _Pragma("unroll") for (int _i = 0; _i < 2; ++_i) { unsigned o_ = (voff)[_i]; asm volatile("" : "+v"(o_));     \
        __builtin_amdgcn_global_load_lds((const unsigned*)((const char*)(gbase) + o_), (LAS unsigned*)(lds + (bufoff) + ldsw + _i * 8192), 16, 0, 0); } } while (0)
#define PG8_LDA(dst, b, h) do { _Pragma("unroll") for (int m = 0; m < 4; ++m) _Pragma("unroll") for (int k = 0; k < 2; ++k) dst[m][k] = *(const LAS bf16x8*)(lds + PG8_SA(b, h) + aoff + m * 2048 + k * 1024); } while (0)
#define PG8_LDB(dst, b, h) do { _Pragma("unroll") for (int n = 0; n < 2; ++n) _Pragma("unroll") for (int k = 0; k < 2; ++k) dst[n][k] = *(const LAS bf16x8*)(lds + PG8_SB(b, h) + boff + n * 2048 + k * 1024); } while (0)
#define PG8_AOFF_L(dst, u) do { const int t_ = 64 * wid + lane_id(); int R0_, C0_, R1_, C1_; stage_rc(t_ * 16, R0_, C0_); stage_rc(t_ * 16 + 8192, R1_, C1_); \
        const int rows_[4] = {R0_, R1_, HALF + R0_, HALF + R1_}; unsigned off_[4]; S.row_off4_lds(lds, u, rows_, off_); \
        dst[0][0] = off_[0] + (unsigned)C0_ * 2u; dst[0][1] = off_[1] + (unsigned)C1_ * 2u; dst[1][0] = off_[2] + (unsigned)C0_ * 2u; dst[1][1] = off_[3] + (unsigned)C1_ * 2u; } while (0)
#define PG8_CAT(x0, x1) __builtin_bit_cast(v8i32, __builtin_shufflevector(x0, x1, 0, 1, 2, 3, 4, 5, 6, 7, 8, 9, 10, 11, 12, 13, 14, 15))
#define PG8_MMA(ai, bj, At, Bt) do { __builtin_amdgcn_s_setprio(1); _Pragma("unroll") for (int m = 0; m < 4; ++m) _Pragma("unroll") for (int n = 0; n < 2; ++n) { \
        if (FP8) acc[ai][bj][m][n] = __builtin_amdgcn_mfma_scale_f32_16x16x128_f8f6f4(PG8_CAT(Bt[n][0], Bt[n][1]), PG8_CAT(At[m][0], At[m][1]), acc[ai][bj][m][n], 0, 0, 0, sc1_, 0, sc1_); \
        else { _Pragma("unroll") for (int k = 0; k < 2; ++k) acc[ai][bj][m][n] = __builtin_amdgcn_mfma_f32_16x16x32_bf16(Bt[n][k], At[m][k], acc[ai][bj][m][n], 0, 0, 0); } } \
        __builtin_amdgcn_s_setprio(0); } while (0)
#define PG8_WAIT_V(n) asm volatile("s_waitcnt vmcnt(" #n ")" ::: "memory")
#define PG8_WAIT_L(n) asm volatile("s_waitcnt lgkmcnt(" #n ")" ::: "memory")
#define PG8_BAR __builtin_amdgcn_s_barrier()
#define PG8_SCHED __builtin_amdgcn_sched_barrier(0)
#define PG8_AOFF(dst, u) do { const int t_ = 64 * wid + lane_id(); int R0_, C0_, R1_, C1_; stage_rc(t_ * 16, R0_, C0_); stage_rc(t_ * 16 + 8192, R1_, C1_); \
        const int rows_[4] = {R0_, R1_, HALF + R0_, HALF + R1_}; unsigned off_[4]; S.row_off4(u, rows_, off_); \
        dst[0][0] = off_[0] + (unsigned)C0_ * 2u; dst[0][1] = off_[1] + (unsigned)C1_ * 2u; dst[1][0] = off_[2] + (unsigned)C0_ * 2u; dst[1][1] = off_[3] + (unsigned)C1_ * 2u; } while (0)
    int sc1_ = 0x7f7f7f7f; asm volatile("" : "+v"(sc1_));
    Unit cur, nxt; int ui = 0;
    if (!S.next(0, cur)) return;
    f32x4 acc[2][2][4][2];
#pragma unroll
    for (int a = 0; a < 2; ++a)
#pragma unroll
        for (int b = 0; b < 2; ++b)
#pragma unroll
            for (int m = 0; m < 4; ++m)
#pragma unroll
                for (int n = 0; n < 2; ++n) acc[a][b][m][n] = (f32x4){0.f, 0.f, 0.f, 0.f};
    bf16x8 At[4][2], B0[2][2], B1[2][2];
    unsigned vA[2][2], vA2[2][2];
    PG8_AOFF(vA, cur);
#pragma unroll
    for (int h = 0; h < 2; ++h)
#pragma unroll
        for (int i = 0; i < 2; ++i) vA2[h][i] = vA[h][i];
    const char* cA = cur.A; const char* cB = cur.B;
    PG8_STAGE(PG8_SB(0, 0), cB, voffB); PG8_STAGE(PG8_SB(0, 1), cB + hstep, voffB); PG8_STAGE(PG8_SA(0, 0), cA, vA[0]); PG8_STAGE(PG8_SA(0, 1), cA, vA[1]);
    if (wr == 1) PG8_BAR;
    PG8_WAIT_V(2); PG8_BAR;
    PG8_STAGE(PG8_SB(1, 0), cB + kstep, voffB); PG8_STAGE(PG8_SA(1, 0), cA + kstep, vA[0]); PG8_STAGE(PG8_SB(1, 1), cB + hstep + kstep, voffB);
    PG8_WAIT_V(6); PG8_BAR;
    for (;;) {
        if constexpr (Epi::KHOOK) E.prep(cur, ui & 1, tid, lds);
        const bool has_next = S.next(ui + 1, nxt);
        const char* nA = has_next ? nxt.A : cA; const char* nB = has_next ? nxt.B : cB;
        if constexpr (Epi::BIAS_LDS) E.bias_dma(lds, cur, ui & 1, wid);
        if (DYN_A) { if (has_next) S.list_dma(lds, nxt, wid); }
#pragma unroll 1
        for (int t = 0; t < nt; t += 2) {
            const bool last = (t == nt - 2);
            const char* a1 = cA + (size_t)(t + 1) * kstep;
            const char* a2 = last ? nA : cA + (size_t)(t + 2) * kstep; const char* b2 = last ? nB : cB + (size_t)(t + 2) * kstep;
            const char* a3 = a2 + kstep; const char* b3 = b2 + kstep;
            if (DYN_A) { if (last && has_next) { PG8_AOFF_L(vA2, nxt); } }
            if constexpr (Epi::KHOOK) { if (t == 4 || t == 10) E.khook(acc, cur, t, wr, lane_id(), ui & 1, lds); }
            PG8_LDB(B0, 0, 0); PG8_LDB(B1, 0, 1); PG8_SCHED; PG8_LDA(At, 0, 0); PG8_STAGE(PG8_SA(1, 1), a1, vA[1]);
            PG8_WAIT_V(8); PG8_WAIT_L(0); PG8_BAR; PG8_MMA(0, 0, At, B0); PG8_MMA(0, 1, At, B1); PG8_BAR; PG8_SCHED;
            PG8_LDA(At, 0, 1); PG8_STAGE(PG8_SB(0, 0), b2, voffB); PG8_STAGE(PG8_SB(0, 1), b2 + hstep, voffB); PG8_STAGE(PG8_SA(0, 0), a2, vA2[0]);
            PG8_WAIT_V(8); PG8_WAIT_L(0); PG8_BAR; PG8_MMA(1, 0, At, B0); PG8_MMA(1, 1, At, B1); PG8_BAR; PG8_SCHED;
            PG8_LDB(B0, 1, 0); PG8_LDB(B1, 1, 1); PG8_SCHED; PG8_LDA(At, 1, 0); PG8_STAGE(PG8_SA(0, 1), a2, vA2[1]);
            PG8_WAIT_V(8); PG8_WAIT_L(0); PG8_BAR; PG8_MMA(0, 0, At, B0); PG8_MMA(0, 1, At, B1); PG8_BAR; PG8_SCHED;
            PG8_LDA(At, 1, 1); PG8_STAGE(PG8_SB(1, 0), b3, voffB); PG8_STAGE(PG8_SB(1, 1), b3 + hstep, voffB); PG8_STAGE(PG8_SA(1, 0), a3, vA2[0]);
            PG8_WAIT_V(8); PG8_WAIT_L(0); PG8_BAR; PG8_MMA(1, 0, At, B0); PG8_MMA(1, 1, At, B1); PG8_BAR; PG8_SCHED;
        }
        if (wr == 0) PG8_BAR;
        if constexpr (Epi::KHOOK) { if (!dry) E.fin(acc, cur, wr, wc, lane_id(), ui & 1, lds); }
        else if (!dry) { if constexpr (Epi::BIAS_LDS) E(acc, cur, wr, wc, lane_id(), ui, lds); else E(acc, cur, wr, wc, lane_id()); }
        else { float sink = 0.f;
#pragma unroll
            for (int a = 0; a < 2; ++a)
#pragma unroll
                for (int b = 0; b < 2; ++b)
#pragma unroll
                    for (int m = 0; m < 4; ++m)
#pragma unroll
                        for (int n = 0; n < 2; ++n) sink += acc[a][b][m][n][0] + acc[a][b][m][n][1] + acc[a][b][m][n][2] + acc[a][b][m][n][3];
            asm volatile("" :: "v"(sink)); }
        if (!has_next) break;
#pragma unroll
        for (int a = 0; a < 2; ++a)
#pragma unroll
            for (int b = 0; b < 2; ++b)
#pragma unroll
                for (int m = 0; m < 4; ++m)
#pragma unroll
                    for (int n = 0; n < 2; ++n) acc[a][b][m][n] = (f32x4){0.f, 0.f, 0.f, 0.f};
        cur = nxt; cA = nA; cB = nB; ++ui;
#pragma unroll
        for (int h = 0; h < 2; ++h)
#pragma unroll
            for (int i = 0; i < 2; ++i) vA[h][i] = vA2[h][i];
        if (wr == 1) PG8_BAR;
    }
    PG8_WAIT_V(0);
    PG8_BAR;
#undef PG8_SA
#undef PG8_SB
#undef PG8_STAGE
#undef PG8_LDA
#undef PG8_LDB
#undef PG8_MMA
#undef PG8_WAIT_V
#undef PG8_WAIT_L
#undef PG8_BAR
#undef PG8_SCHED
#undef PG8_AOFF
#undef PG8_AOFF_L
#undef PG8_CAT
}

struct EpiQKV {
    static constexpr bool PERM = true, KHOOK = false, BIAS_LDS = false;
    bf16_t* Qo; const float* rope; float wsc;
    __device__ __forceinline__ void operator()(const f32x4 (&acc)[2][2][4][2], const Unit& u, int wr, int wc, int ln_) const {
        const int fr = ln_ & 15, fq = (ln_ >> 4) & 3;
        const int region = u.pn >> 2, tcol = (u.pn & 3) * 256;
        bf16_t* base = Qo + (size_t)region * ((WS_K - WS_Q) / 2);
        const float sc = (region == 0 ? QSCALE : 1.0f) * wsc;
#pragma unroll
        for (int bj = 0; bj < 2; ++bj) {
            const int cg = tcol + 128 * bj + 32 * wc, head = cg >> 6;
            const bool rope_on = (region < 2) && (head >= 4) && (head < 10);
            if (!rope_on) {
#pragma unroll
                for (int ai = 0; ai < 2; ++ai)
#pragma unroll
                    for (int m = 0; m < 4; ++m) { const size_t row = (size_t)u.pm * BM + ai * HALF + wr * 64 + m * 16 + fr;
                        const f32x4 v0 = acc[ai][bj][m][0] * sc, v1 = acc[ai][bj][m][1] * sc; u32x4 w;
                        w.x = pk2(v0[0], v0[1]); w.y = pk2(v0[2], v0[3]); w.z = pk2(v1[0], v1[1]); w.w = pk2(v1[2], v1[3]);
                        *(u32x4*)(base + row * DM + cg + 8 * fq) = w; }
            } else {
                const int j0 = 16 * ((cg >> 5) & 1) + 4 * fq;
#pragma unroll
                for (int ai = 0; ai < 2; ++ai)
#pragma unroll
                    for (int m = 0; m < 4; ++m) { const size_t row = (size_t)u.pm * BM + ai * HALF + wr * 64 + m * 16 + fr;
                        const f32x4 v0 = acc[ai][bj][m][0] * sc, v1 = acc[ai][bj][m][1] * sc;
                        const f32x4 cs0 = *(const f32x4*)(rope + row * 64 + 2 * j0), cs1 = *(const f32x4*)(rope + row * 64 + 2 * j0 + 4);
                        const float a0 = v0[0] * cs0[0] - v0[1] * cs0[1], b0 = v0[1] * cs0[0] + v0[0] * cs0[1];
                        const float a1 = v0[2] * cs0[2] - v0[3] * cs0[3], b1 = v0[3] * cs0[2] + v0[2] * cs0[3];
                        const float a2 = v1[0] * cs1[0] - v1[1] * cs1[1], b2 = v1[1] * cs1[0] + v1[0] * cs1[1];
                        const float a3 = v1[2] * cs1[2] - v1[3] * cs1[3], b3 = v1[3] * cs1[2] + v1[2] * cs1[3];
                        u32x2 wa, wb; wa.x = pk2(a0, a1); wa.y = pk2(a2, a3); wb.x = pk2(b0, b1); wb.y = pk2(b2, b3);
                        bf16_t* rp = base + row * DM + head * 64 + j0;
                        *(u32x2*)rp = wa; *(u32x2*)(rp + 32) = wb; }
            }
        }
    }
};
struct EpiOut {
    static constexpr bool PERM = true, KHOOK = (FUSE_ONORM != 0), BIAS_LDS = false;
    const float* base32; const bf16_t* base16; bf16_t* out16; const float* ga; const float* ss;
    __device__ __forceinline__ void prep(const Unit& u, int par, int tid, LAS unsigned char* lds) const {
        if (tid < 256) { const f32x4* sp = (const f32x4*)(ss + 16 * ((size_t)u.pm * BM + tid)); const f32x4 a = sp[0], b = sp[1], c = sp[2], d = sp[3];
            const float s0 = (a[0] + a[1]) + (a[2] + a[3]), s1 = ((b[0] + b[1]) + (b[2] + b[3])) + (c[0] + c[1]), s2 = (c[2] + c[3]) + ((d[0] + d[1]) + (d[2] + d[3]));
            const float r0 = frsq(s0 * (1.0f / 256) + EPS), r1 = frsq(s1 * (1.0f / 384) + EPS), r2 = frsq(s2 * (1.0f / 384) + EPS);
            *(LAS f32x4*)(lds + MISC_OFF + MO_RF + par * 4096 + tid * 16) = (f32x4){r0 * frcp(r1), r1 * frcp(r2), r2, 0.f}; }
    }
    __device__ __forceinline__ void khook(f32x4 (&acc)[2][2][4][2], const Unit& u, int t, int wr, int ln_, int par, LAS unsigned char* lds) const {
        const int fr = ln_ & 15, gp = (t == 4) ? 0 : 1;
#pragma unroll
        for (int ai = 0; ai < 2; ++ai)
#pragma unroll
            for (int m = 0; m < 4; ++m) { const int r = ai * HALF + wr * 64 + m * 16 + fr; const float f = *(const LAS float*)(lds + MISC_OFF + MO_RF + par * 4096 + r * 16 + 4 * gp);
#pragma unroll
                for (int bj = 0; bj < 2; ++bj)
#pragma unroll
                    for (int n = 0; n < 2; ++n) acc[ai][bj][m][n] = acc[ai][bj][m][n] * f; }
    }
    __device__ __forceinline__ void fin(const f32x4 (&acc)[2][2][4][2], const Unit& u, int wr, int wc, int ln_, int par, LAS unsigned char* lds) const {
        const int fr = ln_ & 15, fq = (ln_ >> 4) & 3;
        const int b = (u.pm * BM) / SEQ; const float* gab = ga + (size_t)b * (NMOD * DM);
        float r2[2][4];
#pragma unroll
        for (int ai = 0; ai < 2; ++ai)
#pragma unroll
            for (int m = 0; m < 4; ++m) r2[ai][m] = FUSE_ONORM ? *(const LAS float*)(lds + MISC_OFF + MO_RF + par * 4096 + (ai * HALF + wr * 64 + m * 16 + fr) * 16 + 8) : 1.0f;
#pragma unroll
        for (int bj = 0; bj < 2; ++bj) { const int col = u.pn * BM + bj * HALF + wc * 32 + 8 * fq; const f32x4 g0 = *(const f32x4*)(gab + col), g1 = *(const f32x4*)(gab + col + 4);
#pragma unroll
            for (int ai = 0; ai < 2; ++ai)
#pragma unroll
                for (int m = 0; m < 4; ++m) { const size_t off = ((size_t)u.pm * BM + ai * HALF + wr * 64 + m * 16 + fr) * DM + col; f32x4 b0, b1;
                    if (base32) { b0 = *(const f32x4*)(base32 + off); b1 = *(const f32x4*)(base32 + off + 4); }
                    else { const u32x4 w = *(const u32x4*)(base16 + off); b0 = (f32x4){bf_lo(w.x), bf_hi(w.x), bf_lo(w.y), bf_hi(w.y)}; b1 = (f32x4){bf_lo(w.z), bf_hi(w.z), bf_lo(w.w), bf_hi(w.w)}; }
                    const f32x4 o0 = b0 + (g0 * r2[ai][m]) * acc[ai][bj][m][0], o1 = b1 + (g1 * r2[ai][m]) * acc[ai][bj][m][1];
                    u32x4 w; w.x = pk2(o0[0], o0[1]); w.y = pk2(o0[2], o0[3]); w.z = pk2(o1[0], o1[1]); w.w = pk2(o1[2], o1[3]);
                    *(u32x4*)(out16 + off) = w; } }
    }
    __device__ __forceinline__ void operator()(const f32x4 (&acc)[2][2][4][2], const Unit& u, int wr, int wc, int ln_) const { fin(acc, u, wr, wc, ln_, 0, nullptr); }
};
struct EpiGU {
    static constexpr bool PERM = true, KHOOK = false, BIAS_LDS = true;
    int L;
    __device__ __forceinline__ void bias_dma(LAS unsigned char* lds, const Unit& u, int par, int wid) const {
        if (wid == 0) { const int ln = lane_id(); kargs_t ka = KA(); const float* bgu = ka->in[14] + (size_t)L * NE * 2048;
            const float* p = bgu + (size_t)u.e * 2048 + 128 * u.pn + (ln < 32 ? 4 * ln : 1024 + 4 * (ln - 32));
            __builtin_amdgcn_global_load_lds((const unsigned*)p, (LAS unsigned*)(lds + MISC_OFF + MO_RF + 2048 + par * 1024), 16, 0, 0); }
    }
    __device__ __forceinline__ void operator()(const f32x4 (&acc)[2][2][4][2], const Unit& u, int wr, int wc, int ln_, int ui_, LAS unsigned char* lds) const {
        const int par = ui_ & 1;
        const int fr = ln_ & 15, fq = (ln_ >> 4) & 3;
        kargs_t ka = KA(); unsigned char* act = ka->ws + WS_ACT;
        int blk_ = blockIdx.x; asm volatile("" : "+s"(blk_));
        const int cvi = (ui_ * 256 + blk_) * 8 + wr * 4 + wc;
        const bool cv = EPI_CONV && (L + 1 < DEPTH) && (cvi < 16384) && (gridDim.x == 256);
        f32x4 cvv[16]; const float* cvs = nullptr; unsigned char* cvd = nullptr; int cvn = 0, cvld = 0, cvgu = 0;
        if (cv) { const int g = ln_ >> 3, cq = ln_ & 7; int r = cvi;
            if (r < 16384) { const int e = r / 512, q = r % 512, k0 = 128 * (q / 64), n0 = 32 * (q % 64); cvld = 2048; cvgu = 1; cvn = n0 + 4 * cq;
                cvs = ka->in[13] + ((size_t)(L + 1) * NE + e) * DM * 2048 + (size_t)(k0 + 16 * g) * 2048 + n0 + 4 * cq; cvd = ka->ws + WS_WGU + ((size_t)(L + 1) * NE + e) * 2048 * DM + k0 + 16 * g; }
            else { r -= 16384; const int e = r / 256, q = r % 256, k0 = 128 * (q / 32), n0 = 32 * (q % 32); cvld = DM; cvgu = 0; cvn = n0 + 4 * cq;
                cvs = ka->in[15] + ((size_t)(L + 1) * NE + e) * DM * DM + (size_t)(k0 + 16 * g) * DM + n0 + 4 * cq; cvd = ka->ws + WS_WDN + ((size_t)(L + 1) * NE + e) * DM * DM + k0 + 16 * g; }
#pragma unroll
            for (int i = 0; i < 16; ++i) cvv[i] = *(const f32x4u*)(cvs + (size_t)i * cvld);
        } else {
#pragma unroll
            for (int i = 0; i < 16; ++i) cvv[i] = (f32x4){0.f, 0.f, 0.f, 0.f};
        }
        const int jl = 128 * u.pn + 32 * wc + 8 * fq; const LAS float* bb = (const LAS float*)(lds + MISC_OFF + MO_RF + 2048 + par * 1024) + 32 * wc + 8 * fq;
        const f32x4 bg0 = *(const LAS f32x4*)(bb), bg1 = *(const LAS f32x4*)(bb + 4), bu0 = *(const LAS f32x4*)(bb + 128), bu1 = *(const LAS f32x4*)(bb + 132);
#pragma unroll
        for (int ai = 0; ai < 2; ++ai)
#pragma unroll
            for (int m = 0; m < 4; ++m) { const size_t row = (size_t)u.pm * BM + ai * HALF + wr * 64 + m * 16 + fr;
                float o[8];
#pragma unroll
                for (int n = 0; n < 2; ++n) { const float ws_ = MOE_FP8 ? (1.0f / 32.0f) : 1.0f; const f32x4 gv = acc[ai][0][m][n] * ws_ + (n ? bg1 : bg0), uv = acc[ai][1][m][n] * ws_ + (n ? bu1 : bu0);
#pragma unroll
                    for (int i = 0; i < 4; ++i) { const float g = fminf(gv[i], 7.0f), up = fminf(fmaxf(uv[i], -7.0f), 7.0f);
                        const float sg = frcp(1.0f + fexp2(-1.702f * LOG2E * g)); o[4 * n + i] = (up + 1.0f) * (g * sg); } }
                if (MOE_FP8) { u32x2 w; w.x = pk4_fp8(o[0], o[1], o[2], o[3]); w.y = pk4_fp8(o[4], o[5], o[6], o[7]); *(u32x2*)(act + row * DM + jl) = w; }
                else { u32x4 w; w.x = pk2(o[0], o[1]); w.y = pk2(o[2], o[3]); w.z = pk2(o[4], o[5]); w.w = pk2(o[6], o[7]); *(u32x4*)((bf16_t*)act + row * DM + jl) = w; } }
        if (cv) {
#pragma unroll
            for (int c = 0; c < 4; ++c) { const int n_ = cvn + c; const int prow = cvgu ? ::wrow_map<2>(n_) : ::wrow_map<3>(n_); u32x4 a;
                a.x = pk4_fp8(cvv[0][c] * 32.0f, cvv[1][c] * 32.0f, cvv[2][c] * 32.0f, cvv[3][c] * 32.0f); a.y = pk4_fp8(cvv[4][c] * 32.0f, cvv[5][c] * 32.0f, cvv[6][c] * 32.0f, cvv[7][c] * 32.0f);
                a.z = pk4_fp8(cvv[8][c] * 32.0f, cvv[9][c] * 32.0f, cvv[10][c] * 32.0f, cvv[11][c] * 32.0f); a.w = pk4_fp8(cvv[12][c] * 32.0f, cvv[13][c] * 32.0f, cvv[14][c] * 32.0f, cvv[15][c] * 32.0f);
                *(u32x4*)(cvd + (size_t)prow * DM) = a; }
        }
    }
};
struct EpiDN {
    static constexpr bool PERM = true, KHOOK = false, BIAS_LDS = true;
    int L;
    __device__ __forceinline__ void bias_dma(LAS unsigned char* lds, const Unit& u, int par, int wid) const {
        if (wid == 0) { kargs_t ka = KA(); const float* p = ka->in[16] + (size_t)L * NE * DM + (size_t)u.e * DM + u.pn * BM + 4 * lane_id();
            __builtin_amdgcn_global_load_lds((const unsigned*)p, (LAS unsigned*)(lds + MISC_OFF + MO_RF + 2048 + par * 1024), 16, 0, 0); }
    }
    __device__ __forceinline__ void operator()(const f32x4 (&acc)[2][2][4][2], const Unit& u, int wr, int wc, int ln_, int ui_, LAS unsigned char* lds) const {
        const int par = ui_ & 1;
        const int fr = ln_ & 15, fq = (ln_ >> 4) & 3;
        kargs_t ka = KA(); bf16_t* outb = (bf16_t*)(ka->ws + WS_OUTB); const float* bdn = ka->in[16] + (size_t)L * NE * DM; const int* list = (const int*)(ka->ws + WS_LIST); const float* topg = (const float*)(ka->ws + WS_TOPG);
        const int* lp = list + (size_t)u.e * NTOK + (size_t)u.mt * 256;
        f32x4 bv[2][2];
#pragma unroll
        for (int bj = 0; bj < 2; ++bj)
#pragma unroll
            for (int n = 0; n < 2; ++n) bv[bj][n] = *(const LAS f32x4*)((const LAS float*)(lds + MISC_OFF + MO_RF + 2048 + par * 1024) + 64 * wc + 16 * fq + 8 * bj + 4 * n);
        if (SLOT_OUT && OUT_FP8) {
            unsigned char* ob = (unsigned char*)outb;
#pragma unroll
            for (int ai = 0; ai < 2; ++ai)
#pragma unroll
                for (int m = 0; m < 4; ++m) { const size_t row = (size_t)u.pm * BM + ai * HALF + wr * 64 + m * 16 + fr; u32x4 w16;
#pragma unroll
                    for (int bj = 0; bj < 2; ++bj) { const float ws_ = MOE_FP8 ? (1.0f / 32.0f) : 1.0f;
                        const f32x4 q0 = (acc[ai][bj][m][0] * ws_ + bv[bj][0]) * 16.0f, q1 = (acc[ai][bj][m][1] * ws_ + bv[bj][1]) * 16.0f; f32x4 c0, c1;
#pragma unroll
                        for (int i = 0; i < 4; ++i) { c0[i] = fminf(fmaxf(q0[i], -448.0f), 448.0f); c1[i] = fminf(fmaxf(q1[i], -448.0f), 448.0f); }
                        const unsigned lo = pk4_fp8(c0[0], c0[1], c0[2], c0[3]), hi = pk4_fp8(c1[0], c1[1], c1[2], c1[3]);
                        if (bj == 0) { w16.x = lo; w16.y = hi; } else { w16.z = lo; w16.w = hi; } }
                    *(u32x4*)(ob + row * DM + u.pn * BM + 64 * wc + 16 * fq) = w16; }
            return; }
        static_assert(SLOT_OUT && OUT_FP8 && MOE_FP8, "the other output paths assume the unpermuted w_dn row order");
#pragma unroll
        for (int ai = 0; ai < 2; ++ai)
#pragma unroll
            for (int m = 0; m < 4; ++m) { const int r = ai * HALF + wr * 64 + m * 16 + fr;
                if (r < u.nvalid) { const int ent = lp[r]; const float gw = topg[ent]; bf16_t* rp = outb + (size_t)ent * DM + u.pn * BM + wc * 32 + 8 * fq;
#pragma unroll
                    for (int bj = 0; bj < 2; ++bj) { const float ws_ = MOE_FP8 ? (1.0f / 32.0f) : 1.0f;
                        if (OUT_FP8) { const f32x4 q0 = (acc[ai][bj][m][0] * ws_ + bv[bj][0]) * (gw * 16.0f), q1 = (acc[ai][bj][m][1] * ws_ + bv[bj][1]) * (gw * 16.0f);
                            f32x4 c0, c1;
#pragma unroll
                            for (int i = 0; i < 4; ++i) { c0[i] = fminf(fmaxf(q0[i], -448.0f), 448.0f); c1[i] = fminf(fmaxf(q1[i], -448.0f), 448.0f); }
                            u32x2 w8; w8.x = pk4_fp8(c0[0], c0[1], c0[2], c0[3]); w8.y = pk4_fp8(c1[0], c1[1], c1[2], c1[3]);
                            *(u32x2*)((unsigned char*)outb + (size_t)ent * DM + u.pn * BM + wc * 32 + 8 * fq + bj * HALF) = w8; continue; } const f32x4 v0 = (acc[ai][bj][m][0] * ws_ + bv[bj][0]) * gw, v1 = (acc[ai][bj][m][1] * ws_ + bv[bj][1]) * gw; u32x4 w;
                        w.x = pk2(v0[0], v0[1]); w.y = pk2(v0[2], v0[3]); w.z = pk2(v1[0], v1[1]); w.w = pk2(v1[2], v1[3]);
                        *(u32x4*)(rp + bj * HALF) = w; } } }
    }
};
}

namespace att {
constexpr int OFF_K = 0, OFF_V = 32768, OFF_BIAS = 65536;
__device__ __forceinline__ int crow(int r, int hi) { return (r & 3) + 8 * (r >> 2) + 4 * hi; }
__device__ __forceinline__ float max3f(float a, float b, float c) { float r; asm("v_max3_f32 %0, %1, %2, %3" : "=v"(r) : "v"(a), "v"(b), "v"(c)); return r; }

template <int TYPE>
__device__ __forceinline__ void attn_unit(LAS unsigned char* lds, volatile LAS int* misc, const bf16_t* __restrict__ Q, const bf16_t* __restrict__ Kg, const bf16_t* __restrict__ Vg, bf16_t* __restrict__ O,
                                          const float* __restrict__ lf2, float* __restrict__ ssrow, int b, int head, int qb, const int tid, gu32* qhead) {
    const int wid = __builtin_amdgcn_readfirstlane(tid >> 6), lane = tid & 63, r32 = lane & 31, hh = lane >> 5;
    const int tq = 256 * qb + 32 * wid + r32;
    const size_t grow = (size_t)b * SEQ + tq;
    const int qlo = 256 * qb + 32 * wid, qhi = qlo + 31;
    LAS float* bias = (LAS float*)(lds + OFF_BIAS);
    if (TYPE == 2) {
        const int n = 256 * (qb + 1), i4 = tid * 4;
        f32x4 v = (f32x4){0.f, 0.f, 0.f, 0.f};
        if (i4 < n) v = *(const f32x4*)(lf2 + i4);
        v[1] += v[0]; v[2] += v[1]; v[3] += v[2];
        float tot = v[3], inc = tot;
#pragma unroll
        for (int o = 1; o < 64; o <<= 1) { const float t = __builtin_bit_cast(float, __builtin_amdgcn_ds_bpermute((lane - o) << 2, __builtin_bit_cast(int, inc))); if (lane >= o) inc += t; }
        LAS float* sc = (LAS float*)(misc + (MO_SCAN / 4));
        if (lane == 63) sc[wid] = inc;
        __syncthreads();
        float woff = 0.f;
#pragma unroll
        for (int w = 0; w < 8; ++w) woff += (w < wid) ? sc[w] : 0.f;
        const float ex = woff + inc - tot;
        *(LAS f32x4*)(bias + i4) = (f32x4){ex + v[0], ex + v[1], ex + v[2], ex + v[3]};
        __syncthreads();
        const float cref = bias[n - 1];
        __syncthreads();
        f32x4 c4 = *(LAS f32x4*)(bias + i4); c4 = cref - c4; *(LAS f32x4*)(bias + i4) = c4;
    }
    bf16x8 qf[4];
#pragma unroll
    for (int s = 0; s < 4; ++s) qf[s] = *(const bf16x8*)(Q + grow * DM + head * 64 + 16 * s + 8 * hh);
    float lbn[16];
    if (TYPE == 1) {
#pragma unroll
        for (int r = 0; r < 16; ++r) { const int c = (tq - crow(r, hh)) & 15; const bool m16 = (c == 0), m4 = ((c & 3) == 0);
            lbn[r] = m16 ? 1.5849625007211562f : (m4 ? 1.0f : 0.0f); }
    }
#define LB_MID(v) ((v) > 1.25f ? 1.0f : ((v) > 0.5f ? 0.0f : -INFINITY))
#define LB_FAR(v) ((v) > 1.25f ? 0.0f : -INFINITY)
    const int skv = tid >> 3, sch = tid & 7;
    const unsigned kst = 128u * skv + ((unsigned)(sch ^ ((skv >> 1) & 7)) << 4);
    const unsigned vst = 128u * skv + (((unsigned)sch << 4) ^ (((unsigned)(skv >> 1) & 1u) << 6));
    const bf16_t* kgp = Kg + ((size_t)b * SEQ + skv) * DM + head * 64 + 8 * sch;
    const bf16_t* vgp = Vg + ((size_t)b * SEQ + skv) * DM + head * 64 + 8 * sch;
    const unsigned krd0 = 128u * r32, krd1 = 128u * (r32 + 32);
    const int ksw0 = (r32 >> 1) & 7, ksw1 = ((r32 + 32) >> 1) & 7;
    const int g4 = lane >> 4, q4 = (lane >> 2) & 3, p4 = lane & 3;
    unsigned vrd[2][2];
#pragma unroll
    for (int e = 0; e < 2; ++e)
#pragma unroll
        for (int db = 0; db < 2; ++db) { const int row = 8 * e + 4 * hh + q4; const unsigned bytec = (unsigned)(32 * db + 16 * (g4 & 1) + 4 * p4) * 2u;
            vrd[e][db] = 128u * row + (bytec ^ (((unsigned)(row >> 1) & 1u) << 6)); }

    f32x16 oT[2];
#pragma unroll
    for (int d = 0; d < 2; ++d)
#pragma unroll
        for (int r = 0; r < 16; ++r) oT[d][r] = 0.f;
    float mrun = -1e30f, lrun = 0.f, Rrun = 0.f;

    const int jt_hi = 4 * qb + 3;
    u32x4 kreg0 = *(const u32x4*)(kgp + (size_t)(64 * jt_hi) * DM), vreg0 = *(const u32x4*)(vgp + (size_t)(64 * jt_hi) * DM);
    u32x4 kreg1 = *(const u32x4*)(kgp + (size_t)(64 * (jt_hi - 1)) * DM), vreg1 = *(const u32x4*)(vgp + (size_t)(64 * (jt_hi - 1)) * DM);
    if (tid == 0) misc[MO_Q / 4] = (int)__hip_atomic_fetch_add(qhead, 1u, __ATOMIC_RELAXED, __HIP_MEMORY_SCOPE_AGENT);
    bool stop = false, wdone = false;
    for (int P = jt_hi >> 1; P >= 0 && !stop; --P) {
        const int pb_ = (P & 1) * 16384;
        *(LAS u32x4*)(lds + OFF_K + pb_ + 8192 + kst) = kreg0; *(LAS u32x4*)(lds + OFF_V + pb_ + 8192 + vst) = vreg0;
        *(LAS u32x4*)(lds + OFF_K + pb_ + kst) = kreg1; *(LAS u32x4*)(lds + OFF_V + pb_ + vst) = vreg1;
        __syncthreads();
        if (TYPE == 0) { if (P < (jt_hi >> 1)) { bool alld = true;
#pragma unroll
                for (int w = 0; w < 8; ++w) alld = alld && (misc[(MO_VOTE / 4) + ((P + 1) & 1) * 8 + w] != 0);
                if (alld) break; } }
        if (P > 0) { kreg0 = *(const u32x4*)(kgp + (size_t)(64 * (2 * P - 1)) * DM); vreg0 = *(const u32x4*)(vgp + (size_t)(64 * (2 * P - 1)) * DM);
                     kreg1 = *(const u32x4*)(kgp + (size_t)(64 * (2 * P - 2)) * DM); vreg1 = *(const u32x4*)(vgp + (size_t)(64 * (2 * P - 2)) * DM); }
#pragma unroll 1
        for (int sub = 1; sub >= 0; --sub) {
        const int jt = 2 * P + sub; const int buf = 0; (void)buf;
        const int kv0 = 64 * jt;
        const bool active = (kv0 <= qhi) && !(TYPE == 0 && (kv0 >= qhi || wdone));
        if (active) {
            const LAS unsigned char* Kb = lds + OFF_K + pb_ + sub * 8192; const LAS unsigned char* Vb = lds + OFF_V + pb_ + sub * 8192;
            f32x16 p0, p1; bool negl = false;
            const bool full = (kv0 + 63 <= qlo);
            if (TYPE == 2) {
#pragma unroll
                for (int g = 0; g < 4; ++g) { const f32x4 b0 = *(const LAS f32x4*)(bias + kv0 + 8 * g + 4 * hh), b1 = *(const LAS f32x4*)(bias + kv0 + 32 + 8 * g + 4 * hh);
#pragma unroll
                    for (int j = 0; j < 4; ++j) { p0[4 * g + j] = b0[j]; p1[4 * g + j] = b1[j]; } }
            } else {
#pragma unroll
                for (int r = 0; r < 16; ++r) { p0[r] = 0.f; p1[r] = 0.f; }
            }
            bf16x8 kfa[4], kfb[4];
#pragma unroll
            for (int s = 0; s < 4; ++s) {
                kfa[s] = *(const LAS bf16x8*)(Kb + krd0 + (((2 * s + hh) ^ ksw0) << 4));
                kfb[s] = *(const LAS bf16x8*)(Kb + krd1 + (((2 * s + hh) ^ ksw1) << 4));
            }
            __builtin_amdgcn_sched_barrier(0);
#pragma unroll
            for (int s = 0; s < 4; ++s) {
                p0 = __builtin_amdgcn_mfma_f32_32x32x16_bf16(kfa[s], qf[s], p0, 0, 0, 0);
                p1 = __builtin_amdgcn_mfma_f32_32x32x16_bf16(kfb[s], qf[s], p1, 0, 0, 0);
            }
            if (TYPE == 0) {
                float x0[16], x1[16];
#pragma unroll
                for (int r = 0; r < 16; ++r) {
                    const float z0 = p0[r], z1 = p1[r];
                    float n0 = fminf(-z0, 0.f) - flog2(1.0f + fexp2(-fabsf(z0)));
                    float n1 = fminf(-z1, 0.f) - flog2(1.0f + fexp2(-fabsf(z1)));
                    if (!full) { const int kvp = kv0 + crow(r, hh); if (kvp >= tq) n0 = 0.f; if (kvp + 32 >= tq) n1 = 0.f; }
                    x0[r] = n0; x1[r] = n1; p0[r] = z0 + n0; p1[r] = z1 + n1;
                }
                float T[8], PGm[8];
#pragma unroll
                for (int g = 0; g < 4; ++g) { const float ga = (x0[4 * g] + x0[4 * g + 1]) + (x0[4 * g + 2] + x0[4 * g + 3]), gb = (x1[4 * g] + x1[4 * g + 1]) + (x1[4 * g + 2] + x1[4 * g + 3]);
                    const float pa = xhalf_get(ga, lane), pb2 = xhalf_get(gb, lane); T[g] = ga + pa; T[4 + g] = gb + pb2; PGm[g] = hh == 0 ? pa : 0.f; PGm[4 + g] = hh == 0 ? pb2 : 0.f; }
                float run = 0.f;
#pragma unroll
                for (int g = 7; g >= 0; --g) { const float lg = Rrun + run + PGm[g]; run += T[g]; T[g] = lg; }
                Rrun += run;
#pragma unroll
                for (int g = 0; g < 4; ++g) {
                    { const float b3 = T[g], b2 = b3 + x0[4 * g + 3], b1 = b2 + x0[4 * g + 2], b0 = b1 + x0[4 * g + 1];
                      p0[4 * g + 3] = fexp2(p0[4 * g + 3] + b3); p0[4 * g + 2] = fexp2(p0[4 * g + 2] + b2); p0[4 * g + 1] = fexp2(p0[4 * g + 1] + b1); p0[4 * g] = fexp2(p0[4 * g] + b0); }
                    { const float b3 = T[4 + g], b2 = b3 + x1[4 * g + 3], b1 = b2 + x1[4 * g + 2], b0 = b1 + x1[4 * g + 1];
                      p1[4 * g + 3] = fexp2(p1[4 * g + 3] + b3); p1[4 * g + 2] = fexp2(p1[4 * g + 2] + b2); p1[4 * g + 1] = fexp2(p1[4 * g + 1] + b1); p1[4 * g] = fexp2(p1[4 * g] + b0); }
                }
                if (!full) {
#pragma unroll
                    for (int r = 0; r < 16; ++r) { const int kvp = kv0 + crow(r, hh); if (kvp >= tq) p0[r] = 0.f; if (kvp + 32 >= tq) p1[r] = 0.f; }
                }
            } else {
                if (TYPE == 1) {
                const int dmin = qlo - (kv0 + 63), dmax = qhi - kv0;
                if (dmin > 512) {
#pragma unroll
                    for (int r = 0; r < 16; ++r) { const float c = LB_FAR(lbn[r]); p0[r] += c; p1[r] += c; }
                } else if (dmin > 128 && dmax <= 512) {
#pragma unroll
                    for (int r = 0; r < 16; ++r) { const float c = LB_MID(lbn[r]); p0[r] += c; p1[r] += c; }
                } else if (dmin >= 0 && dmax <= 128) {
#pragma unroll
                    for (int r = 0; r < 16; ++r) { p0[r] += lbn[r]; p1[r] += lbn[r]; }
                } else {
#pragma unroll
                    for (int r = 0; r < 16; ++r) { const int d0 = tq - (kv0 + crow(r, hh)), d1 = d0 - 32; const float vn = lbn[r], vm = LB_MID(vn), vf = LB_FAR(vn);
                        p0[r] += d0 < 0 ? -INFINITY : (d0 <= 128 ? vn : (d0 <= 512 ? vm : vf));
                        p1[r] += d1 < 0 ? -INFINITY : (d1 <= 128 ? vn : (d1 <= 512 ? vm : vf)); }
                }
                }
                if (TYPE == 2 && !full) {
#pragma unroll
                    for (int r = 0; r < 16; ++r) { const int kvp = kv0 + crow(r, hh); if (kvp > tq) p0[r] = -INFINITY; if (kvp + 32 > tq) p1[r] = -INFINITY; }
                }
                float mxa = max3f(p0[0], p0[1], p0[2]), mxb = max3f(p1[0], p1[1], p1[2]);
#pragma unroll
                for (int r = 3; r < 15; r += 2) { mxa = max3f(mxa, p0[r], p0[r + 1]); mxb = max3f(mxb, p1[r], p1[r + 1]); }
                float mx = max3f(mxa, mxb, fmaxf(p0[15], p1[15]));
                negl = (TYPE == 2) && __all(mx < mrun - 40.0f);
                if (!negl) {
                if (__any(mx > mrun + 8.0f)) {
                    mx = fmaxf(mx, xhalf_get(mx, lane));
                    const float mnew = (mx > mrun + 8.0f) ? mx : mrun, alpha = fexp2(mrun - mnew); mrun = mnew;
                    lrun = lrun * alpha;
#pragma unroll
                    for (int d = 0; d < 2; ++d)
#pragma unroll
                        for (int r = 0; r < 16; ++r) oT[d][r] *= alpha;
                }
#pragma unroll
                for (int r = 0; r < 16; ++r) { p0[r] = fexp2(p0[r] - mrun); p1[r] = fexp2(p1[r] - mrun); }
                }
            }
            if (!negl) {
            bf16x8 pb[4];
#pragma unroll
            for (int s = 0; s < 4; ++s) { const f32x16& pp = (s < 2) ? p0 : p1; const int o8 = 8 * (s & 1);
                u32x4 w; w.x = pk2(pp[o8 + 0], pp[o8 + 1]); w.y = pk2(pp[o8 + 2], pp[o8 + 3]); w.z = pk2(pp[o8 + 4], pp[o8 + 5]); w.w = pk2(pp[o8 + 6], pp[o8 + 7]);
                pb[s] = __builtin_bit_cast(bf16x8, w); }
            bf16x8 va[4][2];
#pragma unroll
            for (int s = 0; s < 4; ++s)
#pragma unroll
                for (int db = 0; db < 2; ++db) {
                    const s16x4 lo = __builtin_amdgcn_ds_read_tr16_b64_v4i16((LAS s16x4*)(Vb + vrd[0][db] + 2048u * s));
                    const s16x4 hi = __builtin_amdgcn_ds_read_tr16_b64_v4i16((LAS s16x4*)(Vb + vrd[1][db] + 2048u * s));
                    va[s][db] = (bf16x8){lo[0], lo[1], lo[2], lo[3], hi[0], hi[1], hi[2], hi[3]};
                }
            __builtin_amdgcn_sched_barrier(0);
            if (TYPE != 0) {
                f32x16 rs;
#pragma unroll
                for (int r = 0; r < 16; ++r) rs[r] = 0.f;
                const bf16x8 ones = (bf16x8){0x3F80, 0x3F80, 0x3F80, 0x3F80, 0x3F80, 0x3F80, 0x3F80, 0x3F80};
#pragma unroll
                for (int s = 0; s < 4; ++s) rs = __builtin_amdgcn_mfma_f32_32x32x16_bf16(ones, pb[s], rs, 0, 0, 0);
                lrun += rs[0];
            }
#pragma unroll
            for (int s = 0; s < 4; ++s)
#pragma unroll
                for (int db = 0; db < 2; ++db) oT[db] = __builtin_amdgcn_mfma_f32_32x32x16_bf16(va[s][db], pb[s], oT[db], 0, 0, 0);
            }
        }
        if (TYPE == 0 && sub == 0) {
            const bool done = wdone || (active && __all(Rrun < -64.0f));
            wdone = done;
            if (lane == 0) misc[(MO_VOTE / 4) + (P & 1) * 8 + wid] = done ? 1 : 0;
        }
        }
    }
    float inv = 1.0f;
    if (TYPE != 0) { inv = frcp(lrun); }
    if (FUSE_ONORM) {
        float ssq = 0.f;
#pragma unroll
        for (int db = 0; db < 2; ++db)
#pragma unroll
            for (int r = 0; r < 16; ++r) { const float ov = oT[db][r] * inv; ssq += ov * ov; }
        const float sp = xhalf_get(ssq, lane); const float tot = hh == 0 ? ssq + sp : sp + ssq;
        if (hh == 0) ssrow[16 * grow + head] = tot;
    }
    bf16_t* op = O + grow * DM + head * 64 + 4 * hh;
#pragma unroll
    for (int db = 0; db < 2; ++db)
#pragma unroll
        for (int g = 0; g < 4; ++g) { u32x2 w; w.x = pk2(oT[db][4 * g] * inv, oT[db][4 * g + 1] * inv); w.y = pk2(oT[db][4 * g + 2] * inv, oT[db][4 * g + 3] * inv);
            *(u32x2*)(op + 32 * db + 8 * g) = w; }
    __syncthreads();
}
}

constexpr int N_PHASES = 2 + 8 * DEPTH;

struct Row16 { float v[16]; };
__device__ __forceinline__ Row16 ld_row_f32(const float* p, int lane) { Row16 r; const f32x4 a = *(const f32x4*)(p + 8 * lane), b = *(const f32x4*)(p + 8 * lane + 4), c = *(const f32x4*)(p + 512 + 8 * lane), d = *(const f32x4*)(p + 516 + 8 * lane);
#pragma unroll
    for (int i = 0; i < 4; ++i) { r.v[i] = a[i]; r.v[4 + i] = b[i]; r.v[8 + i] = c[i]; r.v[12 + i] = d[i]; } return r; }
__device__ __forceinline__ void st_row_f32(float* p, int lane, const Row16& r) {
    *(f32x4*)(p + 8 * lane) = (f32x4){r.v[0], r.v[1], r.v[2], r.v[3]}; *(f32x4*)(p + 8 * lane + 4) = (f32x4){r.v[4], r.v[5], r.v[6], r.v[7]};
    *(f32x4*)(p + 512 + 8 * lane) = (f32x4){r.v[8], r.v[9], r.v[10], r.v[11]}; *(f32x4*)(p + 516 + 8 * lane) = (f32x4){r.v[12], r.v[13], r.v[14], r.v[15]}; }
__device__ __forceinline__ Row16 ld_row_bf16(const bf16_t* p, int lane) { Row16 r; const u32x4 a = *(const u32x4*)(p + 8 * lane), c = *(const u32x4*)(p + 512 + 8 * lane);
    r.v[0] = bf_lo(a.x); r.v[1] = bf_hi(a.x); r.v[2] = bf_lo(a.y); r.v[3] = bf_hi(a.y); r.v[4] = bf_lo(a.z); r.v[5] = bf_hi(a.z); r.v[6] = bf_lo(a.w); r.v[7] = bf_hi(a.w);
    r.v[8] = bf_lo(c.x); r.v[9] = bf_hi(c.x); r.v[10] = bf_lo(c.y); r.v[11] = bf_hi(c.y); r.v[12] = bf_lo(c.z); r.v[13] = bf_hi(c.z); r.v[14] = bf_lo(c.w); r.v[15] = bf_hi(c.w); return r; }
__device__ __forceinline__ void st_row_bf16(bf16_t* p, int lane, const Row16& r) { u32x4 a, c;
    a.x = pk2(r.v[0], r.v[1]); a.y = pk2(r.v[2], r.v[3]); a.z = pk2(r.v[4], r.v[5]); a.w = pk2(r.v[6], r.v[7]);
    c.x = pk2(r.v[8], r.v[9]); c.y = pk2(r.v[10], r.v[11]); c.z = pk2(r.v[12], r.v[13]); c.w = pk2(r.v[14], r.v[15]);
    *(u32x4*)(p + 8 * lane) = a; *(u32x4*)(p + 512 + 8 * lane) = c; }

__device__ __forceinline__ Row16 norm_mod(const Row16& x, const float* g, const float* sh, const float* sc, int lane) {
    float ss = 0.f;
#pragma unroll
    for (int i = 0; i < 16; ++i) ss += x.v[i] * x.v[i];
    const float rinv = frsq(wave_sum(ss) * (1.0f / DM) + EPS);
    const Row16 G = ld_row_f32(g, lane), SH = ld_row_f32(sh, lane), SC = ld_row_f32(sc, lane); Row16 h;
#pragma unroll
    for (int i = 0; i < 16; ++i) h.v[i] = (x.v[i] * rinv) * G.v[i] * (1.0f + SC.v[i]) + SH.v[i];
    return h;
}

__device__ __forceinline__ Row16 norm_pre(const Row16& x, const Row16& GS, const Row16& SH) {
    float ss = 0.f;
#pragma unroll
    for (int i = 0; i < 16; ++i) ss += x.v[i] * x.v[i];
    const float rinv = frsq(wave_sum(ss) * (1.0f / DM) + EPS); Row16 h;
#pragma unroll
    for (int i = 0; i < 16; ++i) h.v[i] = (x.v[i] * rinv) * GS.v[i] + SH.v[i];
    return h;
}
__device__ __forceinline__ void ld_gs_sh(const float* g, const float* sh, const float* sc, int lane, Row16& GS, Row16& SH) {
    const Row16 G = ld_row_f32(g, lane), SC = ld_row_f32(sc, lane); SH = ld_row_f32(sh, lane);
#pragma unroll
    for (int i = 0; i < 16; ++i) GS.v[i] = G.v[i] * (1.0f + SC.v[i]);
}
struct Raw8 { u32x4 a, c; };
__device__ __forceinline__ Raw8 ld_raw_bf16(const bf16_t* p, int lane) { Raw8 r; r.a = *(const u32x4*)(p + 8 * lane); r.c = *(const u32x4*)(p + 512 + 8 * lane); return r; }
__device__ __forceinline__ void acc_raw(Row16& s, const Raw8& r) {
    s.v[0] += bf_lo(r.a.x); s.v[1] += bf_hi(r.a.x); s.v[2] += bf_lo(r.a.y); s.v[3] += bf_hi(r.a.y); s.v[4] += bf_lo(r.a.z); s.v[5] += bf_hi(r.a.z); s.v[6] += bf_lo(r.a.w); s.v[7] += bf_hi(r.a.w);
    s.v[8] += bf_lo(r.c.x); s.v[9] += bf_hi(r.c.x); s.v[10] += bf_lo(r.c.y); s.v[11] += bf_hi(r.c.y); s.v[12] += bf_lo(r.c.z); s.v[13] += bf_hi(r.c.z); s.v[14] += bf_lo(r.c.w); s.v[15] += bf_hi(r.c.w); }

struct Raw8f { u32x2 a, c; };
__device__ __forceinline__ Raw8f ld_raw_fp8(const unsigned char* p, int lane) { Raw8f r; r.a = *(const u32x2*)(p + 8 * lane); r.c = *(const u32x2*)(p + 512 + 8 * lane); return r; }
__device__ __forceinline__ void acc_raw8(Row16& s, const Raw8f& r) {
    const unsigned w[4] = {r.a.x, r.a.y, r.c.x, r.c.y};
#pragma unroll
    for (int q = 0; q < 4; ++q) { const f32x2 lo = __builtin_amdgcn_cvt_pk_f32_fp8((int)w[q], false), hi = __builtin_amdgcn_cvt_pk_f32_fp8((int)w[q], true);
        s.v[4 * q] += lo[0]; s.v[4 * q + 1] += lo[1]; s.v[4 * q + 2] += hi[0]; s.v[4 * q + 3] += hi[1]; } }

__device__ __forceinline__ void st_row_h1(bf16_t* hb, unsigned char* hb8, size_t m, int lane, const Row16& h) {
    if (QKV_FP8 != 0) { u32x2 a, c; a.x = pk4_fp8(h.v[0], h.v[1], h.v[2], h.v[3]); a.y = pk4_fp8(h.v[4], h.v[5], h.v[6], h.v[7]); c.x = pk4_fp8(h.v[8], h.v[9], h.v[10], h.v[11]); c.y = pk4_fp8(h.v[12], h.v[13], h.v[14], h.v[15]);
        unsigned char* p = hb8 + m * DM; *(u32x2*)(p + 8 * lane) = a; *(u32x2*)(p + 512 + 8 * lane) = c; }
    if (QKV_FP8 != 1) st_row_bf16(hb + m * DM, lane, h);
}
__device__ __forceinline__ void forget_logits(const Row16& h, const LAS float* wf, const float* bfg, float* lf2, int b, int t, int lane) {
    float fl[6];
#pragma unroll
    for (int j = 0; j < 6; ++j) { const LAS float* w = wf + j * DM; const f32x4 a = *(const LAS f32x4*)(w + 8 * lane), bq = *(const LAS f32x4*)(w + 8 * lane + 4), c = *(const LAS f32x4*)(w + 512 + 8 * lane), d = *(const LAS f32x4*)(w + 516 + 8 * lane);
        float s = 0.f;
#pragma unroll
        for (int i = 0; i < 4; ++i) s += h.v[i] * a[i] + h.v[4 + i] * bq[i] + h.v[8 + i] * c[i] + h.v[12 + i] * d[i];
        fl[j] = wave_sum(s); }
    if (lane < 6) { float y = fl[0];
#pragma unroll
        for (int j = 1; j < 6; ++j) y = (lane == j) ? fl[j] : y;
        y += bfg[lane];
        const float y2 = y * LOG2E; const float ls2 = fminf(y2, 0.f) - flog2(1.0f + fexp2(-fabsf(y2)));
        lf2[((size_t)b * 6 + lane) * SEQ + t] = ls2; }
}
__device__ __forceinline__ void stage_wf(LAS float* wf, const float* w_in_l, int tid) {
    for (int i = tid; i < 6 * DM; i += NTHREADS) { const int j = i / DM, k = i % DM; wf[i] = w_in_l[(size_t)k * NIN + 3072 + j]; }
}

template <int MAP>
__device__ __forceinline__ int wrow_map(int n) {
    if (MAP == 1) { const int region = n >> 10, cn = n & 1023, head = cn >> 6, dd = cn & 63; if (region < 2 && head >= 4 && head < 10) return (region << 10) + (head << 6) + 2 * (dd & 31) + (dd >> 5); return n; }
    if (MAP == 2) { const int half = n >> 10, jn = n & 1023; return 256 * (jn >> 7) + 128 * half + (jn & 127); }
    if (MAP == 3) { const int l = n & 255, wc = l >> 6, rem = l & 63, fq = rem >> 4, bj = (rem >> 3) & 1, c = rem & 7; return (n & ~255) + 128 * bj + 32 * wc + 8 * fq + c; }
    return n;
}
template <int MAP>
__device__ __forceinline__ void transpose_item_fp8(const float* W, int ldw, int k0, int n0, unsigned char* WT, int lane) {
    const int g = lane >> 3, cq = lane & 7;
    f32x4 v[16];
#pragma unroll
    for (int i = 0; i < 16; ++i) v[i] = *(const f32x4u*)(W + (size_t)(k0 + 16 * g + i) * ldw + n0 + 4 * cq) * 32.0f;
#pragma unroll
    for (int c = 0; c < 4; ++c) { const int prow = wrow_map<MAP>(n0 + 4 * cq + c); u32x4 a;
        a.x = pk4_fp8(v[0][c], v[1][c], v[2][c], v[3][c]); a.y = pk4_fp8(v[4][c], v[5][c], v[6][c], v[7][c]); a.z = pk4_fp8(v[8][c], v[9][c], v[10][c], v[11][c]); a.w = pk4_fp8(v[12][c], v[13][c], v[14][c], v[15][c]);
        *(u32x4*)(WT + (size_t)prow * DM + k0 + 16 * g) = a; }
}
template <int MAP, bool SCALE>
__device__ __forceinline__ void transpose_item(const float* W, int ldw, int k0, int n0, bf16_t* WT, const float* ks, int lane) {
    const int g = lane >> 4, cq = lane & 15;
    f32x4 v[16];
#pragma unroll
    for (int i = 0; i < 16; ++i) v[i] = *(const f32x4u*)(W + (size_t)(k0 + 16 * g + i) * ldw + n0 + 4 * cq);
    if (SCALE) {
#pragma unroll
        for (int i = 0; i < 16; ++i) v[i] = v[i] * ks[k0 + 16 * g + i];
    }
#pragma unroll
    for (int c = 0; c < 4; ++c) { const int prow = wrow_map<MAP>(n0 + 4 * cq + c); u32x4 a, bq;
        a.x = pk2(v[0][c], v[1][c]); a.y = pk2(v[2][c], v[3][c]); a.z = pk2(v[4][c], v[5][c]); a.w = pk2(v[6][c], v[7][c]);
        bq.x = pk2(v[8][c], v[9][c]); bq.y = pk2(v[10][c], v[11][c]); bq.z = pk2(v[12][c], v[13][c]); bq.w = pk2(v[14][c], v[15][c]);
        bf16_t* op = WT + (size_t)prow * DM + k0 + 16 * g; *(u32x4*)op = a; *(u32x4*)(op + 8) = bq; }
}


#define x_in   (INF(0))
#define c_in   (INF(1))
#define pos_in ((const int*)INF(2))
#define w_mod  (INF(3))
#define b_mod  (INF(4))
#define g_attn (INF(5))
#define w_in   (INF(6))
#define b_forget (INF(7))
#define g_mix  (INF(8))
#define w_out  (INF(9))
#define g_ffn  (INF(10))
#define w_router (INF(11))
#define b_router (INF(12))
#define w_gu   (INF(13))
#define b_gu   (INF(14))
#define w_dn   (INF(15))
#define b_dn   (INF(16))
#define g_final (INF(17))
#define xres   (ka->out)
#define MOD    WSP(float, WS_MOD)
#define ROPE   WSP(float, WS_ROPE)
#define LF2    WSP(float, WS_LF2)
#define TOPG   WSP(float, WS_TOPG)
#define WRT    WSP(float, WS_WRT)
#define LIST   WSP(int, WS_LIST)
#define POSE   WSP(int, WS_POSE)
#define WIN    WSP(bf16_t, WS_WIN)
#define WOUT   WSP(bf16_t, WS_WOUT)
#define WGU    WSP(bf16_t, WS_WGU)
#define WDN    WSP(bf16_t, WS_WDN)
#define HB     WSP(bf16_t, WS_H)
#define XB16   WSP(bf16_t, WS_X16)
#define HB8    WSP(unsigned char, WS_H8)
#define QB     WSP(bf16_t, WS_Q)
#define KB     WSP(bf16_t, WS_K)
#define VB     WSP(bf16_t, WS_V)
#define OB     WSP(bf16_t, WS_O)
#define ACT    WSP(bf16_t, WS_ACT)
#define OUTB   WSP(bf16_t, WS_OUTB)
#define modL   (MOD + (size_t)L * NB * (NMOD * DM))
#define SSL    WSP(float, WS_SS)

#define PHASE_LOCALS \
    LAS unsigned char* lds = (LAS unsigned char*)lds_raw; \
    volatile LAS int* misc = (volatile LAS int*)(lds + MISC_OFF); (void)misc; \
    int wv_ = wave_arg; asm volatile("" : "+s"(wv_)); const int wave = wv_; int tid_ = 64 * wave + lane_id(); asm volatile("" : "+v"(tid_)); const int tid = tid_, lane = tid & 63; (void)lane; \
    int blk_ = blockIdx.x, G_ = gridDim.x; asm volatile("" : "+s"(blk_), "+s"(G_)); const int G = G_, blk = blk_; \
    const int gw = blk * NWAVES + wave, NGW = G * NWAVES; (void)gw; (void)NGW; \
    kargs_t ka = KA(); gu32* ctl = (gu32*)(ka->ws + WS_CTL); (void)ctl;
#define PHASE_FN __device__ __forceinline__ void

__device__ __forceinline__ void expert_prefix(volatile LAS int* misc, gu32* ctl, int L, int tid) {
    if (tid < 64) { const int e = tid & 31;
        const int c = (int)__hip_atomic_load(ctl + CW_GCNT + 64 * L + e, __ATOMIC_RELAXED, __HIP_MEMORY_SCOPE_AGENT);
        const int t = (c + 255) >> 8; int inc = t;
#pragma unroll
        for (int o = 1; o < 32; o <<= 1) { const int v = __builtin_amdgcn_ds_bpermute(((tid & 63) - o) << 2, inc); if (e >= o) inc += v; }
        if (tid < 32) { misc[(MO_CNT / 4) + e] = c; misc[(MO_PRE / 4) + e] = inc - t; if (e == 31) misc[(MO_PRE / 4) + NE] = inc; } }
}
constexpr int CV_GU = 32 * 16 * 32, CV_DN = 32 * 16 * 16, CV_M = CV_GU + CV_DN, CV_DEF = 8192, CV_KEEP = CV_M - CV_DEF, CV_BATCH = 3;
static_assert(CV_KEEP >= CV_GU, "the deferred items are all w_dn items");
__device__ __forceinline__ void conv_deferred(kargs_t ka, gu32* ctl, int L, int visits, int wave, int lane, volatile LAS int* slot) {
    gu32* head = ctl + CW_CONV + 64 * L;
    for (int v = 0; v < visits; ++v) {
        if (wave == 0 && lane == 0) slot[0] = (int)__hip_atomic_fetch_add(head, (unsigned)(8 * CV_BATCH), __ATOMIC_RELAXED, __HIP_MEMORY_SCOPE_AGENT);
        __syncthreads();
        const int base = __builtin_amdgcn_readfirstlane(slot[0]);
        __syncthreads();
        if (base >= CV_DEF) break;
        for (int k = 0; k < CV_BATCH; ++k) { const int d = base + wave * CV_BATCH + k; if (d >= CV_DEF) break;
            const int r = CV_KEEP + d - CV_GU, e = r / 256, q = r % 256;
            transpose_item_fp8<3>(ka->in[15] + ((size_t)L * NE + e) * DM * DM, DM, 128 * (q / 32), 32 * (q % 32), ka->ws + WS_WDN + ((size_t)L * NE + e) * DM * DM, lane); }
    }
}
PHASE_FN phase_prologue(int wave_arg) { PHASE_LOCALS

        constexpr int I_IN = 16 * 48, I_OUT = 16 * 16, I_GU = 32 * 16 * 32, I_DN = 32 * 16 * 16, I_S = I_IN + I_OUT, I_M = I_GU + I_DN;
        for (int it = gw; it < DEPTH * I_S; it += NGW) {
            const int L = it / I_S; int r = it % I_S;
            if (r < I_IN) { const int kb = r / 48, nb = r % 48; if (QKV_FP8 != 0) transpose_item_fp8<1>(w_in + (size_t)L * DM * NIN, NIN, 128 * (r / 96), 32 * (r % 96), WSP(unsigned char, WS_WIN8) + (size_t)L * 3072 * DM, lane); if (QKV_FP8 != 1) transpose_item<1, false>(w_in + (size_t)L * DM * NIN, NIN, 64 * kb, 64 * nb, WIN + (size_t)L * 3072 * DM, nullptr, lane); continue; } r -= I_IN;
            { const int kb = r / 16, nb = r % 16; transpose_item<0, true>(w_out + (size_t)L * DM * DM, DM, 64 * kb, 64 * nb, WOUT + (size_t)L * DM * DM, g_mix + (size_t)L * DM, lane); }
        }
        if (MOE_FP8) {
            struct TItem { const float* src; unsigned char* dst; int ldw, nn, gu; };
            constexpr int KEEPR = EPI_CONV ? I_M : CV_KEEP;
            auto mk = [&](int j) -> TItem { TItem t; int L = 0, r = j; if (j >= I_M) { const int jj = j - I_M; L = 1 + jj / KEEPR; r = jj % KEEPR; } const int g = lane >> 3, cq = lane & 7;
                if (r < I_GU) { const int e = r / 512, q = r % 512, k0 = 128 * (q / 64), n0 = 32 * (q % 64); t.ldw = 2048; t.gu = 1; t.nn = n0 + 4 * cq;
                    t.src = w_gu + ((size_t)L * NE + e) * DM * 2048 + (size_t)(k0 + 16 * g) * 2048 + n0 + 4 * cq; t.dst = (unsigned char*)WGU + ((size_t)L * NE + e) * 2048 * DM + k0 + 16 * g; }
                else { r -= I_GU; const int e = r / 256, q = r % 256, k0 = 128 * (q / 32), n0 = 32 * (q % 32); t.ldw = DM; t.gu = 0; t.nn = n0 + 4 * cq;
                    t.src = w_dn + ((size_t)L * NE + e) * DM * DM + (size_t)(k0 + 16 * g) * DM + n0 + 4 * cq; t.dst = (unsigned char*)WDN + ((size_t)L * NE + e) * DM * DM + k0 + 16 * g; }
                return t; };
#define TI_LOAD(V, T) _Pragma("unroll") for (int i = 0; i < 16; ++i) V[i] = *(const f32x4u*)((T).src + (size_t)i * (T).ldw);
#define TI_STORE(V, T) _Pragma("unroll") for (int c = 0; c < 4; ++c) { const int n_ = (T).nn + c; const int prow = (T).gu ? wrow_map<2>(n_) : wrow_map<3>(n_); u32x4 a; \
                a.x = pk4_fp8(V[0][c] * 32.0f, V[1][c] * 32.0f, V[2][c] * 32.0f, V[3][c] * 32.0f); a.y = pk4_fp8(V[4][c] * 32.0f, V[5][c] * 32.0f, V[6][c] * 32.0f, V[7][c] * 32.0f); \
                a.z = pk4_fp8(V[8][c] * 32.0f, V[9][c] * 32.0f, V[10][c] * 32.0f, V[11][c] * 32.0f); a.w = pk4_fp8(V[12][c] * 32.0f, V[13][c] * 32.0f, V[14][c] * 32.0f, V[15][c] * 32.0f); \
                *(u32x4*)((T).dst + (size_t)prow * DM) = a; }
            static_assert(I_M == CV_M && I_GU == CV_GU, "item spaces");
            const int TOT = (EPI_CONV && G == 256) ? I_M : I_M + (DEPTH - 1) * KEEPR;
            f32x4 va[16], vb[16];
            TItem A = mk(gw), B = A;
            if (gw < TOT) { TI_LOAD(va, A) }
            for (int j = gw; j < TOT; j += 2 * NGW) {
                const bool hb = (j + NGW < TOT);
                if (hb) { B = mk(j + NGW); TI_LOAD(vb, B) }
                TI_STORE(va, A)
                if (j + 2 * NGW < TOT) { A = mk(j + 2 * NGW); TI_LOAD(va, A) }
                if (hb) { TI_STORE(vb, B) }
            }
#undef TI_LOAD
#undef TI_STORE
        } else {
            for (int it = gw; it < DEPTH * I_M; it += NGW) { const int L = it / I_M; int r = it % I_M;
                if (r < I_GU) { const int e = r / 512, q = r % 512, kb = q / 32, nb = q % 32; transpose_item<2, false>(w_gu + ((size_t)L * NE + e) * DM * 2048, 2048, 64 * kb, 64 * nb, WGU + ((size_t)L * NE + e) * 2048 * DM, nullptr, lane); continue; } r -= I_GU;
                { const int e = r / 256, q = r % 256, kb = q / 16, nb = q % 16; transpose_item<0, false>(w_dn + ((size_t)L * NE + e) * DM * DM, DM, 64 * kb, 64 * nb, WDN + ((size_t)L * NE + e) * DM * DM, nullptr, lane); }
            }
        }
        for (int i = blk * NTHREADS + tid; i < DEPTH * NE * DM; i += G * NTHREADS) { const int L = i / (NE * DM), r = i % (NE * DM), e = r / DM, k = r % DM; WRT[i] = w_router[((size_t)L * DM + k) * NE + e]; }
        for (int i = blk * NTHREADS + tid; i < NTOK * 32; i += G * NTHREADS) {
            const int row = i >> 5, j = i & 31;
            const float invf = fexp2(-(float)j * (13.287712379549449f / 32.0f));
            const float ang = (float)pos_in[row] * invf;
            const double a = (double)ang; const double kq = rint(a * 0.63661977236758134308); const double r = fma(-kq, 1.57079632679489661923, a), r2 = r * r;
            const double sn = r * (1.0 + r2 * (-1.0 / 6 + r2 * (1.0 / 120 + r2 * (-1.0 / 5040 + r2 * (1.0 / 362880 + r2 * (-1.0 / 39916800))))));
            const double cs = 1.0 + r2 * (-0.5 + r2 * (1.0 / 24 + r2 * (-1.0 / 720 + r2 * (1.0 / 40320 + r2 * (-1.0 / 3628800 + r2 * (1.0 / 479001600))))));
            const int qd = ((int)kq) & 3; double c, s;
            if (qd == 0) { c = cs; s = sn; } else if (qd == 1) { c = -sn; s = cs; } else if (qd == 2) { c = -cs; s = -sn; } else { c = sn; s = -cs; }
            ROPE[2 * (size_t)i] = (float)c; ROPE[2 * (size_t)i + 1] = (float)s;
        }
        {
            LAS float* cact = (LAS float*)(lds);
            LAS float* red = (LAS float*)(lds + 65536);
            for (int i = lane; i < 128 * 16; i += 64) { const int bb = i >> 7, kk = i & 127; const float cv = c_in[bb * DM + 128 * wave + kk]; cact[wave * 2048 + kk * 16 + bb] = cv * frcp(1.0f + fexp2(-cv * LOG2E)); }
            __syncthreads();
            for (int tk = blk; tk < DEPTH * 96; tk += G) {
                const int L = tk / 96, j0 = 64 * (tk % 96);
                const float* wp = w_mod + ((size_t)L * DM + 128 * wave) * (NMOD * DM) + j0 + lane;
                float acc[16];
#pragma unroll
                for (int bb = 0; bb < 16; ++bb) acc[bb] = 0.f;
#pragma unroll 1
                for (int kb = 0; kb < 128; kb += 16) {
                    float wv[16];
#pragma unroll
                    for (int i = 0; i < 16; ++i) wv[i] = wp[(size_t)(kb + i) * (NMOD * DM)];
#pragma unroll
                    for (int i = 0; i < 16; ++i) { const LAS f32x4* cp = (const LAS f32x4*)(cact + wave * 2048 + (kb + i) * 16);
#pragma unroll
                        for (int q = 0; q < 4; ++q) { const f32x4 cc = cp[q]; acc[4 * q] += wv[i] * cc[0]; acc[4 * q + 1] += wv[i] * cc[1]; acc[4 * q + 2] += wv[i] * cc[2]; acc[4 * q + 3] += wv[i] * cc[3]; }
                        if ((i & 3) == 3) __builtin_amdgcn_sched_barrier(0); } }
#pragma unroll
                for (int bb = 0; bb < 16; ++bb) red[(wave * 16 + bb) * 64 + lane] = acc[bb];
                __syncthreads();
                for (int o = tid; o < 1024; o += NTHREADS) { const int bb = o >> 6, cl = o & 63; float s = 0.f;
#pragma unroll
                    for (int w = 0; w < 8; ++w) s += red[(w * 16 + bb) * 64 + cl];
                    MOD[((size_t)L * NB + bb) * (NMOD * DM) + j0 + cl] = s + b_mod[(size_t)L * (NMOD * DM) + j0 + cl]; }
                __syncthreads();
            }
        }
    }
PHASE_FN phase_norm0(int wave_arg) { PHASE_LOCALS
    LAS float* wf = (LAS float*)lds; stage_wf(wf, w_in, tid); __syncthreads();
    const int RPW = NTOK / NGW;
    if (RPW * NGW == NTOK && (RPW & 1) == 0 && (SEQ % RPW) == 0) {
        const int m0 = gw * RPW, b = m0 >> 11; const float* modb = MOD + (size_t)b * (NMOD * DM);
        Row16 GS, SH; ld_gs_sh(g_attn, modb, modb + DM, lane, GS, SH);
        for (int m = m0; m < m0 + RPW; m += 2) {
            const Row16 xa = ld_row_f32(x_in + (size_t)m * DM, lane), xb = ld_row_f32(x_in + (size_t)(m + 1) * DM, lane);
            const Row16 ha = norm_pre(xa, GS, SH), hb = norm_pre(xb, GS, SH);
            st_row_h1(HB, HB8, (size_t)m, lane, ha); st_row_h1(HB, HB8, (size_t)(m + 1), lane, hb);
            forget_logits(ha, wf, b_forget, LF2, b, m & (SEQ - 1), lane); forget_logits(hb, wf, b_forget, LF2, b, (m + 1) & (SEQ - 1), lane); }
    } else {
        for (int m = gw; m < NTOK; m += NGW) { const int b = m >> 11, t = m & (SEQ - 1); const float* modb = MOD + (size_t)b * (NMOD * DM);
            const Row16 x = ld_row_f32(x_in + (size_t)m * DM, lane); const Row16 h = norm_mod(x, g_attn, modb, modb + DM, lane);
            st_row_h1(HB, HB8, (size_t)m, lane, h); forget_logits(h, wf, b_forget, LF2, b, t, lane); }
    }
    __syncthreads();
}
PHASE_FN phase_qkv(int L_, int wave_arg, int dry_ = 0) { const int L = __builtin_amdgcn_readfirstlane(L_); const bool dry = __builtin_amdgcn_readfirstlane(dry_) != 0; PHASE_LOCALS

            if (QKV_FP8 != 1) {
                pg8::StaticOrder S; S.init(HB, WIN + (size_t)L * 3072 * DM, NTOK, 3072, G, blk); if (QKV_FP8 == 2) S.restrict_cols(0xBA98ull, 4);
                pg8::EpiQKV E{QB, ROPE, 1.0f};
                pg8::gemm_phase<pg8::EpiQKV, pg8::StaticOrder, false>(lds, wave, S, E, dry); }
            if (QKV_FP8 != 0) {
                pg8::StaticOrderT<pg8::KK> S; S.init(HB8, WSP(unsigned char, WS_WIN8) + (size_t)L * 3072 * DM, NTOK, 3072, G, blk); if (QKV_FP8 == 2) S.restrict_cols(0x76543210ull, 8);
                pg8::EpiQKV E{QB, ROPE, 1.0f / 32.0f};
                pg8::gemm_phase<pg8::EpiQKV, pg8::StaticOrderT<pg8::KK>, false, true>(lds, wave, S, E, dry); }
        }
PHASE_FN phase_attn(int L_, int rep_, int wave_arg) { const int L = __builtin_amdgcn_readfirstlane(L_), rep = __builtin_amdgcn_readfirstlane(rep_); PHASE_LOCALS

    volatile LAS int* qslot = misc + (MO_Q / 4);
#define ATT_QUEUE(QI, NUNITS, ...) do { gu32* head = ctl + CW_AQ + 64 * (3 * L + (QI)) + 1024 * rep; \
        if (tid == 0) qslot[0] = (int)__hip_atomic_fetch_add(head, 1u, __ATOMIC_RELAXED, __HIP_MEMORY_SCOPE_AGENT); \
        __syncthreads(); \
        for (;;) { const int idx = qslot[0]; __syncthreads(); if (idx >= (NUNITS)) break; \
            int tl = tid; asm volatile("" : "+v"(tl)); __VA_ARGS__ } __syncthreads(); } while (0)
    const int amask = rep ? REP_ATT_MASK : 7;
    if (amask & 2) ATT_QUEUE(0, 768, { const int qb = 7 - idx / 96, rem = idx % 96, b = rem / 6, hd = 4 + rem % 6; att::attn_unit<1>(lds, misc, QB, KB, VB, OB, nullptr, SSL, b, hd, qb, tl, head); });
    if (amask & 4) ATT_QUEUE(1, 768, { const int qb = 7 - idx / 96, rem = idx % 96, b = rem / 6, hd = 10 + rem % 6; att::attn_unit<2>(lds, misc, QB, KB, VB, OB, LF2 + ((size_t)b * 6 + (hd - 10)) * SEQ, SSL, b, hd, qb, tl, head); });
    if (amask & 1) ATT_QUEUE(2, 512, { const int qb = 7 - idx / 64, b = (idx % 64) / 4, hd = idx % 4; att::attn_unit<0>(lds, misc, QB, KB, VB, OB, nullptr, SSL, b, hd, qb, tl, head); });
#undef ATT_QUEUE
}
PHASE_FN phase_onorm(int L_, int wave_arg) { const int L = __builtin_amdgcn_readfirstlane(L_); PHASE_LOCALS
    (void)L;
    const int RPW = (NTOK + NGW - 1) / NGW, m0 = gw * RPW, m1 = (m0 + RPW < NTOK) ? m0 + RPW : NTOK;
    for (int m = m0; m < m1; m += 4) {
        Raw8 r[4];
#pragma unroll
        for (int j = 0; j < 4; ++j) if (m + j < m1) r[j] = ld_raw_bf16(OB + (size_t)(m + j) * DM, lane);
#pragma unroll
        for (int j = 0; j < 4; ++j) if (m + j < m1) {
            Row16 o;
#pragma unroll
            for (int i = 0; i < 16; ++i) o.v[i] = 0.f;
            acc_raw(o, r[j]);
            float sa = 0.f, sb = 0.f;
#pragma unroll
            for (int i = 0; i < 8; ++i) { sa += o.v[i] * o.v[i]; sb += o.v[8 + i] * o.v[8 + i]; }
            const float s0 = wave_sum(lane < 32 ? sa : 0.f), s1 = wave_sum((lane >= 32 ? sa : 0.f) + (lane < 16 ? sb : 0.f)), s2 = wave_sum(lane >= 16 ? sb : 0.f);
            const float r0 = frsq(s0 * (1.0f / 256) + EPS), r1 = frsq(s1 * (1.0f / 384) + EPS), r2 = frsq(s2 * (1.0f / 384) + EPS);
            const float fa = lane < 32 ? r0 : r1, fb = lane < 16 ? r1 : r2;
#pragma unroll
            for (int i = 0; i < 8; ++i) { o.v[i] *= fa; o.v[8 + i] *= fb; }
            st_row_bf16(OB + (size_t)(m + j) * DM, lane, o); }
    }
}
PHASE_FN phase_outproj(int L_, int wave_arg, int dry_) { const int L = __builtin_amdgcn_readfirstlane(L_), dry = __builtin_amdgcn_readfirstlane(dry_); PHASE_LOCALS

            pg8::StaticOrder S; S.init(OB, WOUT + (size_t)L * DM * DM, NTOK, DM, G, blk);
            pg8::EpiOut E{L == 0 ? x_in : nullptr, XB16, dry ? QB : XB16, modL + 2 * DM, SSL};
            pg8::gemm_phase<pg8::EpiOut, pg8::StaticOrder, false>(lds, wave, S, E);
        }
__device__ __forceinline__ void split_bf16(const f32x4& a, const f32x4& b, bf16x8& hi, bf16x8& lo) {
    u32x4 h; h.x = pk2(a[0], a[1]); h.y = pk2(a[2], a[3]); h.z = pk2(b[0], b[1]); h.w = pk2(b[2], b[3]);
    u32x4 l; l.x = pk2(a[0] - bf_lo(h.x), a[1] - bf_hi(h.x)); l.y = pk2(a[2] - bf_lo(h.y), a[3] - bf_hi(h.y)); l.z = pk2(b[0] - bf_lo(h.z), b[1] - bf_hi(h.z)); l.w = pk2(b[2] - bf_lo(h.w), b[3] - bf_hi(h.w));
    hi = __builtin_bit_cast(bf16x8, h); lo = __builtin_bit_cast(bf16x8, l);
}
PHASE_FN phase_route(int L_, int wave_arg, int dry_ = 0) { const int L = __builtin_amdgcn_readfirstlane(L_); const bool dry = __builtin_amdgcn_readfirstlane(dry_) != 0; PHASE_LOCALS
    if (MOE_FP8 && !dry && L >= 1 && G == 256) conv_deferred(KA(), ctl, L, 1 << 20, wave, lane, (volatile LAS int*)(lds + MISC_OFF + MO_Q + 4));
    constexpr int HS = DM + 4;
    LAS float* hbuf = (LAS float*)lds;
    LAS float* part = (LAS float*)(lds + 69632);
    volatile LAS int* ent = misc + (MO_ENT / 4); volatile LAS int* hist = misc + (MO_HIST / 4); volatile LAS int* basep = misc + (MO_BASE / 4);
    const int e32 = lane & 31, kh = lane >> 5;
    const int mi = lane & 15, kk4 = lane >> 4, k0 = 128 * wave + 32 * kk4;
    bf16x8 wh[2][4], wl[2][4];
#pragma unroll
    for (int x = 0; x < 2; ++x) { const f32x4* wp = (const f32x4*)(WRT + ((size_t)L * NE + 16 * x + mi) * DM + k0);
#pragma unroll
      for (int j = 0; j < 4; ++j) { const f32x4 w0 = wp[2 * j], w1 = wp[2 * j + 1]; split_bf16(w0, w1, wh[x][j], wl[x][j]); } }
    const float brt = b_router[(size_t)L * NE + e32];
    for (int chunk = blk; chunk < NTOK / 128; chunk += G) {
        if (tid < NE) hist[tid] = 0;
        Row16 GS2, SH2; { const int b = (chunk * 128) >> 11; const float* modb = modL + (size_t)b * (NMOD * DM); ld_gs_sh(g_ffn + (size_t)L * DM, modb + 3 * DM, modb + 4 * DM, lane, GS2, SH2); }
        Row16 xna, xnb;
        { const int m0_ = chunk * 128 + 2 * wave; xna = ld_row_bf16(XB16 + (size_t)m0_ * DM, lane); xnb = ld_row_bf16(XB16 + (size_t)(m0_ + 1) * DM, lane); }
#pragma unroll 1
        for (int sub = 0; sub < 8; ++sub) {
            { const int ma = chunk * 128 + 16 * sub + 2 * wave;
              const Row16 xa = xna, xb = xnb;
              if (sub + 1 < 8) { xna = ld_row_bf16(XB16 + (size_t)(ma + 16) * DM, lane); xnb = ld_row_bf16(XB16 + (size_t)(ma + 17) * DM, lane); }
              const Row16 hq[2] = {norm_pre(xa, GS2, SH2), norm_pre(xb, GS2, SH2)};
#pragma unroll
              for (int j = 0; j < 2; ++j) { const Row16& h = hq[j]; const int rl = 2 * wave + j, m = ma + j;
                if (!MOE_FP8) st_row_bf16((bf16_t*)HB8 + (size_t)m * DM, lane, h); else
                { u32x2 a, c; a.x = pk4_fp8(h.v[0], h.v[1], h.v[2], h.v[3]); a.y = pk4_fp8(h.v[4], h.v[5], h.v[6], h.v[7]); c.x = pk4_fp8(h.v[8], h.v[9], h.v[10], h.v[11]); c.y = pk4_fp8(h.v[12], h.v[13], h.v[14], h.v[15]);
                  unsigned char* hp8 = HB8 + (size_t)m * DM; *(u32x2*)(hp8 + 8 * lane) = a; *(u32x2*)(hp8 + 512 + 8 * lane) = c; }
                LAS float* hr = hbuf + rl * HS;
                *(LAS f32x4*)(hr + 8 * lane) = (f32x4){h.v[0], h.v[1], h.v[2], h.v[3]}; *(LAS f32x4*)(hr + 8 * lane + 4) = (f32x4){h.v[4], h.v[5], h.v[6], h.v[7]};
                *(LAS f32x4*)(hr + 512 + 8 * lane) = (f32x4){h.v[8], h.v[9], h.v[10], h.v[11]}; *(LAS f32x4*)(hr + 516 + 8 * lane) = (f32x4){h.v[12], h.v[13], h.v[14], h.v[15]}; } }
            asm volatile("s_waitcnt lgkmcnt(0)\n\ts_barrier" ::: "memory");
            { f32x4 c0 = (f32x4){0.f, 0.f, 0.f, 0.f}, c1 = c0; const LAS f32x4* hp = (const LAS f32x4*)(hbuf + mi * HS + k0);
#pragma unroll
              for (int j = 0; j < 4; ++j) { const f32x4 h0 = hp[2 * j], h1 = hp[2 * j + 1]; bf16x8 ah, al; split_bf16(h0, h1, ah, al);
                  c0 = __builtin_amdgcn_mfma_f32_16x16x32_bf16(ah, wh[0][j], c0, 0, 0, 0); c1 = __builtin_amdgcn_mfma_f32_16x16x32_bf16(ah, wh[1][j], c1, 0, 0, 0);
                  c0 = __builtin_amdgcn_mfma_f32_16x16x32_bf16(ah, wl[0][j], c0, 0, 0, 0); c1 = __builtin_amdgcn_mfma_f32_16x16x32_bf16(ah, wl[1][j], c1, 0, 0, 0);
                  c0 = __builtin_amdgcn_mfma_f32_16x16x32_bf16(al, wh[0][j], c0, 0, 0, 0); c1 = __builtin_amdgcn_mfma_f32_16x16x32_bf16(al, wh[1][j], c1, 0, 0, 0); }
#pragma unroll
              for (int r = 0; r < 4; ++r) { part[((4 * kk4 + r) * 8 + wave) * 32 + mi] = c0[r]; part[((4 * kk4 + r) * 8 + wave) * 32 + 16 + mi] = c1[r]; } }
            asm volatile("s_waitcnt lgkmcnt(0)\n\ts_barrier" ::: "memory");
            { const int rl = 2 * wave + kh, rowl = 16 * sub + rl, m = chunk * 128 + rowl; float v = brt;
#pragma unroll
              for (int w = 0; w < 8; ++w) v += part[(rl * 8 + w) * 32 + e32];
              float tv[4]; int te[4];
#pragma unroll
              for (int k = 0; k < 4; ++k) { const float mx = half_max(v);
                  const unsigned long long bl = __ballot(v == mx); const unsigned mine = (unsigned)(bl >> (32 * kh)); const int ln = __builtin_ctz(mine);
                  tv[k] = mx; te[k] = ln; if (e32 == ln) v = -INFINITY; }
              const float e1 = fexp2((tv[1] - tv[0]) * LOG2E), e2 = fexp2((tv[2] - tv[0]) * LOG2E), e3 = fexp2((tv[3] - tv[0]) * LOG2E), isum = frcp(1.0f + e1 + e2 + e3);
              if (e32 < 4) { const float gk = (e32 == 0 ? 1.0f : (e32 == 1 ? e1 : (e32 == 2 ? e2 : e3))) * isum; const int ek = e32 == 0 ? te[0] : (e32 == 1 ? te[1] : (e32 == 2 ? te[2] : te[3]));
                  TOPG[(size_t)m * 4 + e32] = gk; ent[rowl * 4 + e32] = ek; } }
            asm volatile("s_waitcnt lgkmcnt(0)\n\ts_barrier" ::: "memory");
        }
        if (dry) { __syncthreads(); continue; }
        const int ek = ent[tid]; const int lr = atomicAdd((int*)(hist + ek), 1);
        __syncthreads();
        if (tid < NE) basep[tid] = (int)__hip_atomic_fetch_add(ctl + CW_GCNT + 64 * L + tid, (unsigned)hist[tid], __ATOMIC_RELAXED, __HIP_MEMORY_SCOPE_AGENT);
        __syncthreads();
        LIST[(size_t)ek * NTOK + basep[ek] + lr] = (chunk * 128 + (tid >> 2)) * 4 + (tid & 3);
        if (SLOT_OUT) POSE[(size_t)(chunk * 128) * 4 + tid] = (ek << 16) | (basep[ek] + lr);
        __syncthreads();
    }
}
PHASE_FN phase_gemm1(int L_, int wave_arg, int dry_ = 0) { const int L = __builtin_amdgcn_readfirstlane(L_); const bool dry = __builtin_amdgcn_readfirstlane(dry_) != 0; PHASE_LOCALS

            volatile LAS int* pre = misc + (MO_PRE / 4); volatile LAS int* cntl = misc + (MO_CNT / 4);
            expert_prefix(misc, ctl, L, tid); (void)cntl;
            __syncthreads();
            { volatile LAS int* t2e = misc + (MO_T2E / 4);
              for (int M = tid; M < 576; M += NTHREADS) { int e = 0;
#pragma unroll 1
                  for (int k = 1; k < NE; ++k) e += (M >= pre[k]) ? 1 : 0;
                  t2e[M] = e; } }
            __syncthreads();

            pg8::MoeOrder<8, true> S; S.MT = misc[(MO_PRE / 4) + NE]; S.G = G; S.c = blk; S.L = L; S.pre = (const LAS int*)(lds + MISC_OFF + MO_PRE);
            pg8::EpiGU E{L};
            pg8::gemm_phase<pg8::EpiGU, pg8::MoeOrder<8, true>, true, MOE_FP8 != 0>(lds, wave, S, E, dry);
            if (MOE_FP8 && !dry && L + 1 < DEPTH && G == 256) {
                const int tot = S.MT * 8; pg8::Unit tu;
                if ((tot & 255) != 0 && !S.next(tot >> 8, tu)) conv_deferred(KA(), (gu32*)(KA()->ws + WS_CTL), L + 1, 2, wave, lane_id(), (volatile LAS int*)(lds + MISC_OFF + MO_Q + 4));
            }
        }
PHASE_FN phase_gemm2(int L_, int wave_arg, int dry_ = 0) { const int L = __builtin_amdgcn_readfirstlane(L_); const bool dry = __builtin_amdgcn_readfirstlane(dry_) != 0; PHASE_LOCALS

            volatile LAS int* pre = misc + (MO_PRE / 4); volatile LAS int* cntl = misc + (MO_CNT / 4);
            expert_prefix(misc, ctl, L, tid); (void)cntl;
            __syncthreads();
            { volatile LAS int* t2e = misc + (MO_T2E / 4);
              for (int M = tid; M < 576; M += NTHREADS) { int e = 0;
#pragma unroll 1
                  for (int k = 1; k < NE; ++k) e += (M >= pre[k]) ? 1 : 0;
                  t2e[M] = e; } }
            __syncthreads();

            pg8::MoeOrder<4, false> S; S.MT = misc[(MO_PRE / 4) + NE]; S.G = G; S.c = blk; S.L = L; S.pre = (const LAS int*)(lds + MISC_OFF + MO_PRE);
            pg8::EpiDN E{L};
            pg8::gemm_phase<pg8::EpiDN, pg8::MoeOrder<4, false>, false, MOE_FP8 != 0>(lds, wave, S, E, dry);
            if (MOE_FP8 && !dry && L + 1 < DEPTH && G == 256) {
                const int tot = S.MT * 4; pg8::Unit tu;
                if ((tot & 255) != 0 && !S.next(tot >> 8, tu)) conv_deferred(KA(), (gu32*)(KA()->ws + WS_CTL), L + 1, 2, wave, lane_id(), (volatile LAS int*)(lds + MISC_OFF + MO_Q + 4));
            }
        }
PHASE_FN phase_combine(int L_, int wave_arg, int dry_ = 0) { const int L = __builtin_amdgcn_readfirstlane(L_); const bool dry = __builtin_amdgcn_readfirstlane(dry_) != 0; PHASE_LOCALS
    bf16_t* xdst16 = dry ? QB : XB16; float* xfin = dry ? (float*)KB : xres;
    LAS float* wf = (LAS float*)lds;
    volatile LAS int* pre = misc + (MO_PRE / 4);
    if (SLOT_OUT) expert_prefix(misc, ctl, L, tid);
    if (L + 1 < DEPTH) stage_wf(wf, w_in + (size_t)(L + 1) * DM * NIN, tid);
    __syncthreads();
    const int RPW = NTOK / NGW;
    if (RPW * NGW == NTOK && (RPW & 1) == 0 && (SEQ % RPW) == 0) {
        const int m0 = gw * RPW, b = m0 >> 11; const float* modb = modL + (size_t)b * (NMOD * DM);
        const Row16 GA = ld_row_f32(modb + 5 * DM, lane);
        Row16 GS, SH;
        if (L + 1 < DEPTH) { const float* modn = MOD + ((size_t)(L + 1) * NB + b) * (NMOD * DM); ld_gs_sh(g_attn + (size_t)(L + 1) * DM, modn, modn + DM, lane, GS, SH); }
        else { GS = ld_row_f32(g_final, lane);
#pragma unroll
            for (int i = 0; i < 16; ++i) SH.v[i] = 0.f; }
        for (int m = m0; m < m0 + RPW; m += 2) {
            Row16 xa = ld_row_bf16(XB16 + (size_t)m * DM, lane), xb = ld_row_bf16(XB16 + (size_t)(m + 1) * DM, lane);
            Row16 sa, sb;
#pragma unroll
            for (int i = 0; i < 16; ++i) { sa.v[i] = 0.f; sb.v[i] = 0.f; }
            if (OUT_FP8 && SLOT_OUT) { Raw8f ya[4], yb[4]; const unsigned char* ob8 = (const unsigned char*)OUTB;
                const u32x4 pa = *(const u32x4*)(POSE + (size_t)m * 4), pb = *(const u32x4*)(POSE + (size_t)(m + 1) * 4); const f32x4 ga4 = *(const f32x4*)(TOPG + (size_t)m * 4), gb4 = *(const f32x4*)(TOPG + (size_t)(m + 1) * 4);
#pragma unroll
                for (int k = 0; k < 4; ++k) { const unsigned ea = pa[k], eb = pb[k];
                    const size_t ra = (size_t)pre[ea >> 16] * 256 + (ea & 0xffffu), rb = (size_t)pre[eb >> 16] * 256 + (eb & 0xffffu);
                    ya[k] = ld_raw_fp8(ob8 + ra * DM, lane); yb[k] = ld_raw_fp8(ob8 + rb * DM, lane); }
#pragma unroll
                for (int k = 0; k < 4; ++k) { Row16 ta, tb;
#pragma unroll
                    for (int i = 0; i < 16; ++i) { ta.v[i] = 0.f; tb.v[i] = 0.f; }
                    acc_raw8(ta, ya[k]); acc_raw8(tb, yb[k]); const float wa = ga4[k] * (1.0f / 16.0f), wb = gb4[k] * (1.0f / 16.0f);
#pragma unroll
                    for (int i = 0; i < 16; ++i) { sa.v[i] += wa * ta.v[i]; sb.v[i] += wb * tb.v[i]; } }
            } else if (OUT_FP8) { Raw8f ya[4], yb[4]; const unsigned char* ob8 = (const unsigned char*)OUTB;
#pragma unroll
                for (int k = 0; k < 4; ++k) { ya[k] = ld_raw_fp8(ob8 + ((size_t)m * 4 + k) * DM, lane); yb[k] = ld_raw_fp8(ob8 + ((size_t)(m + 1) * 4 + k) * DM, lane); }
#pragma unroll
                for (int k = 0; k < 4; ++k) { acc_raw8(sa, ya[k]); acc_raw8(sb, yb[k]); }
#pragma unroll
                for (int i = 0; i < 16; ++i) { sa.v[i] *= (1.0f / 16.0f); sb.v[i] *= (1.0f / 16.0f); }
            } else { Raw8 ya[4], yb[4];
#pragma unroll
                for (int k = 0; k < 4; ++k) { ya[k] = ld_raw_bf16(OUTB + ((size_t)m * 4 + k) * DM, lane); yb[k] = ld_raw_bf16(OUTB + ((size_t)(m + 1) * 4 + k) * DM, lane); }
#pragma unroll
                for (int k = 0; k < 4; ++k) { acc_raw(sa, ya[k]); acc_raw(sb, yb[k]); } }
#pragma unroll
            for (int i = 0; i < 16; ++i) { xa.v[i] += GA.v[i] * sa.v[i]; xb.v[i] += GA.v[i] * sb.v[i]; }
            const Row16 ha = norm_pre(xa, GS, SH), hb = norm_pre(xb, GS, SH);
            if (L + 1 < DEPTH) {
                st_row_bf16(xdst16 + (size_t)m * DM, lane, xa); st_row_bf16(xdst16 + (size_t)(m + 1) * DM, lane, xb);
                st_row_h1(HB, HB8, (size_t)m, lane, ha); st_row_h1(HB, HB8, (size_t)(m + 1), lane, hb);
                forget_logits(ha, wf, b_forget + (size_t)(L + 1) * 6, LF2, b, m & (SEQ - 1), lane); forget_logits(hb, wf, b_forget + (size_t)(L + 1) * 6, LF2, b, (m + 1) & (SEQ - 1), lane);
            } else { st_row_f32(xfin + (size_t)m * DM, lane, ha); st_row_f32(xfin + (size_t)(m + 1) * DM, lane, hb); }
        }
    } else {
        for (int m = gw; m < NTOK; m += NGW) { const int b = m >> 11, t = m & (SEQ - 1); const float* modb = modL + (size_t)b * (NMOD * DM);
            Row16 x = ld_row_bf16(XB16 + (size_t)m * DM, lane);
            Row16 sy;
#pragma unroll
            for (int i = 0; i < 16; ++i) sy.v[i] = 0.f;
#pragma unroll
            for (int k = 0; k < 4; ++k) {
                if (OUT_FP8 && SLOT_OUT) { const unsigned ep = (unsigned)POSE[(size_t)m * 4 + k]; const size_t rr = (size_t)pre[ep >> 16] * 256 + (ep & 0xffffu); Row16 tt;
#pragma unroll
                    for (int i = 0; i < 16; ++i) tt.v[i] = 0.f;
                    acc_raw8(tt, ld_raw_fp8((const unsigned char*)OUTB + rr * DM, lane)); const float wk = TOPG[(size_t)m * 4 + k];
#pragma unroll
                    for (int i = 0; i < 16; ++i) sy.v[i] += wk * tt.v[i]; }
                else if (OUT_FP8) acc_raw8(sy, ld_raw_fp8((const unsigned char*)OUTB + ((size_t)m * 4 + k) * DM, lane)); else acc_raw(sy, ld_raw_bf16(OUTB + ((size_t)m * 4 + k) * DM, lane)); }
            const Row16 ga = ld_row_f32(modb + 5 * DM, lane);
#pragma unroll
            for (int i = 0; i < 16; ++i) x.v[i] += ga.v[i] * sy.v[i] * (OUT_FP8 ? (1.0f / 16.0f) : 1.0f);
            if (L + 1 < DEPTH) { st_row_bf16(xdst16 + (size_t)m * DM, lane, x);
                const float* modn = MOD + ((size_t)(L + 1) * NB + b) * (NMOD * DM);
                const Row16 h = norm_mod(x, g_attn + (size_t)(L + 1) * DM, modn, modn + DM, lane);
                st_row_h1(HB, HB8, (size_t)m, lane, h); forget_logits(h, wf, b_forget + (size_t)(L + 1) * 6, LF2, b, t, lane);
            } else { float ss = 0.f;
#pragma unroll
                for (int i = 0; i < 16; ++i) ss += x.v[i] * x.v[i];
                const float rinv = frsq(wave_sum(ss) * (1.0f / DM) + EPS); const Row16 gf = ld_row_f32(g_final, lane);
#pragma unroll
                for (int i = 0; i < 16; ++i) x.v[i] = x.v[i] * rinv * gf.v[i];
                st_row_f32(xfin + (size_t)m * DM, lane, x); }
        }
    }
    __syncthreads();
}

__global__ void __launch_bounds__(NTHREADS, 2) hybrid_fwd(Args args) {
    LAS unsigned char* lds = (LAS unsigned char*)lds_raw;
    const int wv = __builtin_amdgcn_readfirstlane((int)threadIdx.x >> 6);
    for (int u = threadIdx.x; u < (LDS_BYTES - MISC_OFF) / 4; u += NTHREADS) ((LAS unsigned*)(lds + MISC_OFF))[u] = 0u;
    __syncthreads();
    unsigned* barw = (unsigned*)(args.ws + WS_CTL) + CW_BAR;
    XcdBarrier bar; bar.bar = barw; bar.x = 0; bar.st = nullptr; bar.wave = wv;
    if (N_LAUNCHES == 1) bar = xcd_barrier_post(barw, (volatile LAS unsigned*)(lds + MISC_OFF + MO_BAR));
    bar.wave = wv;
    const int lo = args.ph_lo, hi = args.ph_hi;
#define IN(k) (lo <= (k) && (k) < hi)
#define SEAM(k) do { if (IN(k) && IN((k) + 1)) xcd_barrier(bar); } while (0)
    if (EN(0) && IN(0)) { phase_prologue(wv); for (int r = 0; r < REP_PRO; ++r) phase_prologue(wv); }
    SEAM(0);
    if (EN(1) && IN(1)) phase_norm0(wv);
    SEAM(1);
    for (int L = 0; L < DEPTH; ++L) {
        const int P = 2 + 8 * L;
        if (EN(2) && IN(P + 0)) { phase_qkv(L, wv); for (int r = 0; r < REP_QKV; ++r) phase_qkv(L, wv); for (int r = 0; r < REP_DRYQKV; ++r) phase_qkv(L, wv, 1); }
        SEAM(P + 0);
        if (EN(3) && IN(P + 1)) { phase_attn(L, 0, wv); for (int r = 0; r < REP_ATT; ++r) phase_attn(L, 1 + r, wv); }
        SEAM(P + 1);
        if (!FUSE_ONORM) { if (EN(4) && IN(P + 2)) { phase_onorm(L, wv); for (int r = 0; r < REP_ONORM; ++r) phase_onorm(L, wv); }
        SEAM(P + 2); }
        if (EN(5) && IN(P + 3)) { for (int r = 0; r < REP_OUT; ++r) phase_outproj(L, wv, 1); phase_outproj(L, wv, 0); }
        SEAM(P + 3);
        if (EN(6) && IN(P + 4)) { for (int r = 0; r < REP_ROUTE; ++r) phase_route(L, wv, 1); phase_route(L, wv); }
        SEAM(P + 4);
        if (EN(7) && IN(P + 5)) { phase_gemm1(L, wv); for (int r = 0; r < REP_G1; ++r) phase_gemm1(L, wv); for (int r = 0; r < REP_DRYG1; ++r) phase_gemm1(L, wv, 1); }
        SEAM(P + 5);
        if (EN(8) && IN(P + 6)) { phase_gemm2(L, wv); for (int r = 0; r < REP_G2; ++r) phase_gemm2(L, wv); for (int r = 0; r < REP_DRYG2; ++r) phase_gemm2(L, wv, 1); }
        SEAM(P + 6);
        if (EN(9) && IN(P + 7)) { for (int r = 0; r < REP_COMB; ++r) phase_combine(L, wv, 1); phase_combine(L, wv); }
        SEAM(P + 7);
    }
#undef IN
#undef SEAM
}


#if N_LAUNCHES == 0 && defined(DBG_CHK)
constexpr size_t WS_CHKPREV = 1700 * MiB;
constexpr int CW_CHK = 32768;
__global__ void chk_kernel(const unsigned* p, size_t nwords, unsigned* acc) {
    unsigned s = 0; for (size_t i = (size_t)blockIdx.x * blockDim.x + threadIdx.x; i < nwords; i += (size_t)gridDim.x * blockDim.x) s += p[i] * 2654435761u + (unsigned)(i & 0xffff) * p[i];
    for (int o = 1; o < 64; o <<= 1) s += __shfl_xor(s, o);
    if ((threadIdx.x & 63) == 0) atomicAdd(acc, s);
}
__global__ void chk_list_kernel(const int* list, const unsigned* gcnt, unsigned* acc) {
    const int e = blockIdx.x; const unsigned n = gcnt[e]; unsigned s = n * 977u;
    for (unsigned i = threadIdx.x; i < n; i += blockDim.x) { const unsigned v = (unsigned)list[(size_t)e * NTOK + i]; s += v * 2654435761u + (v >> 7); }
    for (int o = 1; o < 64; o <<= 1) s += __shfl_xor(s, o);
    if ((threadIdx.x & 63) == 0) atomicAdd(acc, s);
}
__global__ void chk_fin(unsigned* cur, unsigned* prev, float* scale, int n) {
    int first = -1; for (int k = 0; k < n; ++k) { if (prev[k] != 0xAAAAAAAAu && prev[k] != cur[k] && first < 0) first = k; }
    for (int k = 0; k < n; ++k) prev[k] = cur[k];
    float sc = 1.0f; if (first >= 0) { sc = 1.6f; for (int k = 0; k < first; ++k) sc = 1.0f + (sc - 1.0f) * 0.6f; }
    *scale = sc;
}
__global__ void chk_scale(float* out, size_t n, const float* scale) { const float sc = *scale; for (size_t i = (size_t)blockIdx.x * blockDim.x + threadIdx.x; i < n; i += (size_t)gridDim.x * blockDim.x) out[i] *= sc; }
#endif

extern "C" void kernel_launch(void* const* d_in, const int* in_sizes, int n_in, void* d_out, int out_size, void* d_ws, size_t ws_size, hipStream_t stream) {
    static int grid = 0;
    if (grid == 0) {
        if (n_in != 18 || out_size != NTOK * DM || ws_size < WS_END) { fprintf(stderr, "kernel_launch: unexpected shapes (n_in %d, out %d, ws %zu)\n", n_in, out_size, ws_size); grid = -1; return; }
        int dev = 0, cus = 0, per_cu = 0;
        if (hipGetDevice(&dev) != hipSuccess || hipDeviceGetAttribute(&cus, hipDeviceAttributeMultiprocessorCount, dev) != hipSuccess) { grid = -1; return; }
        if (hipFuncSetAttribute((const void*)hybrid_fwd, hipFuncAttributeMaxDynamicSharedMemorySize, LDS_BYTES) != hipSuccess) { fprintf(stderr, "kernel_launch: hipFuncSetAttribute failed\n"); grid = -1; return; }
        if (hipOccupancyMaxActiveBlocksPerMultiprocessor(&per_cu, (const void*)hybrid_fwd, NTHREADS, LDS_BYTES) != hipSuccess || per_cu < 1) fprintf(stderr, "kernel_launch: occupancy query reports %d\n", per_cu);
        (void)hipGetLastError();
        grid = cus;
    }
    if (grid < 0) return;
    if (hipMemsetAsync((char*)d_ws + WS_CTL, 0, CTL_ZERO_BYTES, stream) != hipSuccess) return;
    Args a{};
    for (int i = 0; i < 18; ++i) a.in[i] = (const float*)d_in[i];
    a.out = (float*)d_out; a.ws = (unsigned char*)d_ws;
#if N_LAUNCHES == 1
    a.ph_lo = 0; a.ph_hi = N_PHASES;
    hipLaunchKernelGGL(hybrid_fwd, dim3(grid), dim3(NTHREADS), LDS_BYTES, stream, a);
#else
    for (int p = 0; p < N_PHASES; ++p) { a.ph_lo = p; a.ph_hi = p + 1; hipLaunchKernelGGL(hybrid_fwd, dim3(grid), dim3(NTHREADS), LDS_BYTES, stream, a);
#if defined(DBG_CHK)
        unsigned char* w = (unsigned char*)d_ws; unsigned* cur = (unsigned*)(w + WS_CTL) + CW_CHK;
#define CHK(k, off, bytes) hipLaunchKernelGGL(chk_kernel, dim3(1024), dim3(256), 0, stream, (const unsigned*)(w + (off)), (size_t)(bytes) / 4, cur + (k))
        if (p == 2) { CHK(0, WS_MOD, 4 * MiB); CHK(0, WS_ROPE, 8 * MiB); CHK(0, WS_WIN, 800 * MiB); CHK(0, WS_WRT, 512 * 1024); CHK(0, WS_LF2, 768 * 1024); CHK(0, WS_Q, 192 * MiB); }
        if (p == 3) { CHK(1, WS_O, 64 * MiB); }
        if (p == 5) { hipLaunchKernelGGL(chk_kernel, dim3(1024), dim3(256), 0, stream, (const unsigned*)d_out, (size_t)NTOK * DM, cur + 2); }
        if (p == 6) { CHK(3, WS_H, 64 * MiB); CHK(3, WS_TOPG, 512 * 1024); hipLaunchKernelGGL(chk_list_kernel, dim3(32), dim3(256), 0, stream, (const int*)(w + WS_LIST), (const unsigned*)(w + WS_CTL) + CW_GCNT, cur + 3); }
        if (p == 8) { CHK(4, WS_OUTB, 256 * MiB); }
        if (p == 9) { hipLaunchKernelGGL(chk_kernel, dim3(1024), dim3(256), 0, stream, (const unsigned*)d_out, (size_t)NTOK * DM, cur + 5); }
#endif
    }
#if defined(DBG_CHK)
    { unsigned char* w = (unsigned char*)d_ws; unsigned* cur = (unsigned*)(w + WS_CTL) + CW_CHK;
      hipLaunchKernelGGL(chk_fin, dim3(1), dim3(1), 0, stream, cur, (unsigned*)(w + WS_CHKPREV), (float*)(cur + 64), 6);
      hipLaunchKernelGGL(chk_scale, dim3(1024), dim3(256), 0, stream, (float*)d_out, (size_t)NTOK * DM, (const float*)(cur + 64)); }
#endif
#endif
}
```

```cpp
#include <hip/hip_runtime.h>
#include <cstdio>
#include <cstdint>
#include <cmath>

#ifndef N_LAUNCHES
#define N_LAUNCHES 1
#endif
#ifndef PH_MASK
#define PH_MASK 0xFFFF
#endif
#define EN(k) ((PH_MASK >> (k)) & 1)
#ifndef ATT_MASK
#define ATT_MASK 7
#endif
#ifndef MOE_FP8
#define MOE_FP8 1
#endif
#ifndef X16
#define X16 1
#endif
#ifndef SLOT_OUT
#define SLOT_OUT 1
#endif
#ifndef FUSE_ONORM
#define FUSE_ONORM 1
#endif
#ifndef QKV_FP8
#define QKV_FP8 2
#endif
#ifndef OUT_FP8
#define OUT_FP8 1
#endif
#ifndef REP_DRYQKV
#define REP_DRYQKV 0
#endif
#ifndef REP_DRYG1
#define REP_DRYG1 0
#endif
#ifndef REP_DRYG2
#define REP_DRYG2 0
#endif
#ifndef REP_ONORM
#define REP_ONORM 0
#endif
#ifndef REP_OUT
#define REP_OUT 0
#endif
#ifndef REP_COMB
#define REP_COMB 0
#endif
#ifndef REP_ROUTE
#define REP_ROUTE 0
#endif
#ifndef REP_ATT_MASK
#define REP_ATT_MASK 7
#endif
#ifndef REP_ATT
#define REP_ATT 0
#endif
#ifndef REP_QKV
#define REP_QKV 0
#endif
#ifndef REP_G1
#define REP_G1 0
#endif
#ifndef REP_G2
#define REP_G2 0
#endif
#ifndef REP_PRO
#define REP_PRO 0
#endif

#define LAS __attribute__((address_space(3)))
#define GAS __attribute__((address_space(1)))
typedef unsigned short bf16_t;
typedef short bf16x8 __attribute__((ext_vector_type(8)));
typedef short s16x4 __attribute__((ext_vector_type(4)));
typedef float f32x2 __attribute__((ext_vector_type(2)));
typedef float f32x4 __attribute__((ext_vector_type(4)));
typedef float f32x4u __attribute__((ext_vector_type(4), aligned(4)));
typedef float f32x16 __attribute__((ext_vector_type(16)));
typedef unsigned u32x2 __attribute__((ext_vector_type(2)));
typedef unsigned u32x4 __attribute__((ext_vector_type(4)));
typedef int v8i32 __attribute__((ext_vector_type(8)));
typedef __bf16 bf16x2_t __attribute__((ext_vector_type(2)));
typedef GAS unsigned gu32;

constexpr int DM = 1024, NB = 16, SEQ = 2048, NTOK = NB * SEQ, DEPTH = 4, NIN = 3078, NE = 32, NMOD = 6;
constexpr float LOG2E = 1.4426950408889634f;
constexpr float QSCALE = 0.125f * LOG2E;
constexpr float EPS = 1e-6f;
constexpr int NWAVES = 8, NTHREADS = 512;

constexpr size_t MiB = 1u << 20;
constexpr size_t WS_CTL = 0, CTL_ZERO_BYTES = 1 * MiB;
constexpr size_t WS_SS = 2 * MiB;
constexpr size_t WS_MOD = 4 * MiB;
constexpr size_t WS_ROPE = 8 * MiB;
constexpr size_t WS_LF2 = 16 * MiB;
constexpr size_t WS_TOPG = 17 * MiB;
constexpr size_t WS_WRT = 18 * MiB;
constexpr size_t WS_LIST = 20 * MiB;
constexpr size_t WS_POSE = 24 * MiB;
constexpr size_t WS_WIN = 32 * MiB;
constexpr size_t WS_WOUT = 56 * MiB;
constexpr size_t WS_WGU = 64 * MiB;
constexpr size_t WS_WDN = 576 * MiB;
constexpr size_t WS_H = 832 * MiB;
constexpr size_t WS_Q = 896 * MiB, WS_K = 960 * MiB, WS_V = 1024 * MiB, WS_O = 1088 * MiB;
constexpr size_t WS_ACT = 1152 * MiB;
constexpr size_t WS_OUTB = 1424 * MiB;
constexpr size_t WS_H8 = 1680 * MiB;
constexpr size_t WS_WIN8 = 1744 * MiB;
constexpr size_t WS_X16 = 1760 * MiB;
constexpr size_t WS_END = 1824 * MiB;
constexpr int CW_BAR = 4096;
constexpr int CW_GCNT = 16384;
#ifndef EPI_CONV
#define EPI_CONV 1
#endif
constexpr int CW_CONV = 24576;
constexpr int CW_AQ = 20480;

constexpr int RING_BYTES = 131072;
constexpr int MISC_OFF = RING_BYTES;
constexpr int LDS_BYTES = 147456;
constexpr int MO_BAR = 0, MO_Q = 16, MO_VOTE = 64, MO_SCAN = 128, MO_PRE = 256, MO_CNT = 512, MO_HIST = 1024, MO_BASE = 1152, MO_ENT = 2048, MO_T2E = 4096, MO_RF = 8192;

__device__ __forceinline__ int lane_id() { int l; asm volatile("v_mbcnt_lo_u32_b32 %0, -1, 0\n\tv_mbcnt_hi_u32_b32 %0, -1, %0" : "=v"(l)); return l; }
#ifndef DBG_SHFL
#define DBG_SHFL 0
#endif
#define DPP_F(v, ctrl, rmask) __builtin_bit_cast(float, __builtin_amdgcn_update_dpp(0, __builtin_bit_cast(int, (float)(v)), (ctrl), (rmask), 0xf, true))
__device__ __forceinline__ float wave_sum(float v) {
    if (DBG_SHFL & 1) { for (int o = 1; o < 64; o <<= 1) v += __shfl_xor(v, o); return v; }
    v += DPP_F(v, 0xB1, 0xf); v += DPP_F(v, 0x4E, 0xf); v += DPP_F(v, 0x141, 0xf); v += DPP_F(v, 0x140, 0xf);
    v += DPP_F(v, 0x142, 0xa); v += DPP_F(v, 0x143, 0xc);
    return __builtin_bit_cast(float, __builtin_amdgcn_readlane(__builtin_bit_cast(int, v), 63));
}
#define DPP_FM(v, ctrl, rmask) __builtin_bit_cast(float, __builtin_amdgcn_update_dpp(__builtin_bit_cast(int, (float)(v)), __builtin_bit_cast(int, (float)(v)), (ctrl), (rmask), 0xf, false))
__device__ __forceinline__ float wave_max(float v) {
    v = fmaxf(v, DPP_FM(v, 0xB1, 0xf)); v = fmaxf(v, DPP_FM(v, 0x4E, 0xf)); v = fmaxf(v, DPP_FM(v, 0x141, 0xf)); v = fmaxf(v, DPP_FM(v, 0x140, 0xf));
    v = fmaxf(v, DPP_FM(v, 0x142, 0xa)); v = fmaxf(v, DPP_FM(v, 0x143, 0xc));
    return __builtin_bit_cast(float, __builtin_amdgcn_readlane(__builtin_bit_cast(int, v), 63));
}
__device__ __forceinline__ float half_max(float v) {
    if (DBG_SHFL & 2) { for (int o = 1; o < 32; o <<= 1) v = fmaxf(v, __shfl_xor(v, o)); return v; }
    v = fmaxf(v, DPP_FM(v, 0xB1, 0xf)); v = fmaxf(v, DPP_FM(v, 0x4E, 0xf)); v = fmaxf(v, DPP_FM(v, 0x141, 0xf)); v = fmaxf(v, DPP_FM(v, 0x140, 0xf));
    return fmaxf(v, __builtin_bit_cast(float, __builtin_amdgcn_ds_swizzle(__builtin_bit_cast(int, v), 0x401F)));
}
__device__ __forceinline__ float xhalf_get(float v, int lane) { return __builtin_bit_cast(float, __builtin_amdgcn_ds_bpermute((lane ^ 32) << 2, __builtin_bit_cast(int, v))); }
__device__ __forceinline__ float xhalf_sum(float v, int lane) { return v + xhalf_get(v, lane); }
__device__ __forceinline__ unsigned pk2(float lo, float hi) { f32x2 v = {lo, hi}; bf16x2_t b = __builtin_convertvector(v, bf16x2_t); return __builtin_bit_cast(unsigned, b); }
__device__ __forceinline__ unsigned pk4_fp8(float a, float b, float c, float d) { int p = __builtin_amdgcn_cvt_pk_fp8_f32(a, b, 0, false); p = __builtin_amdgcn_cvt_pk_fp8_f32(c, d, p, true); return (unsigned)p; }
__device__ __forceinline__ float bf_lo(unsigned u) { return __uint_as_float(u << 16); }
__device__ __forceinline__ float bf_hi(unsigned u) { return __uint_as_float(u & 0xffff0000u); }
__device__ __forceinline__ float fexp2(float x) { return __builtin_amdgcn_exp2f(x); }
__device__ __forceinline__ float flog2(float x) { return __builtin_amdgcn_logf(x); }
__device__ __forceinline__ float frcp(float x) { return __builtin_amdgcn_rcpf(x); }
__device__ __forceinline__ float frsq(float x) { return __builtin_amdgcn_rsqf(x); }

#define XB_TMO      128
#define XB_XCNT(j)  (256  + 64 * (j))
#define XB_XSUB(j)  (1280 + 64 * (j))
#define XB_XGEN(j)  (2304 + 64 * (j))
#define XB_TOP      3328
#define XB_TOPGEN   3392
#define XCD_BAR_WORDS 3456
#define XB_SPIN_CAP (1u << 22)
__device__ __forceinline__ unsigned xb_ld(unsigned* p)              { return __hip_atomic_load(p, __ATOMIC_RELAXED, __HIP_MEMORY_SCOPE_AGENT); }
__device__ __forceinline__ unsigned xb_add(unsigned* p, unsigned v) { return __hip_atomic_fetch_add(p, v, __ATOMIC_RELAXED, __HIP_MEMORY_SCOPE_AGENT); }
__device__ __forceinline__ unsigned xb_xcc_id() { return (unsigned)__builtin_amdgcn_s_getreg((3 << 11) | 20) & 0xFu; }
#define XB_SPIN(cond, bar) do { unsigned _sp = 0; while (cond) { __builtin_amdgcn_s_sleep(1); \
    if ((++_sp & 255u) == 0u) { if (xb_ld(&(bar)[XB_TMO])) break; if (_sp > XB_SPIN_CAP) { atomicAdd(&(bar)[XB_TMO], 1u); break; } } } } while (0)
struct XcdBarrier { unsigned* bar; unsigned x; volatile LAS unsigned* st; int wave; };
__device__ __forceinline__ XcdBarrier xcd_barrier_post(unsigned* bar, volatile LAS unsigned* st) {
    XcdBarrier b; b.bar = bar; b.x = xb_xcc_id(); b.st = st; b.wave = 0;
    if (threadIdx.x == 0) (void)xb_add(&bar[XB_XCNT(b.x)], 1u);
    return b;
}
__device__ __forceinline__ void xcd_barrier_complete(unsigned* bar, unsigned x, unsigned& nloc, unsigned& nx) {
    const unsigned G = gridDim.x * gridDim.y * gridDim.z;
    unsigned sum, cnt, mine, sp = 0u;
    for (;;) {
        sum = 0u; cnt = 0u; mine = 0u;
#pragma unroll
        for (unsigned j = 0; j < 16; ++j) { const unsigned c = xb_ld(&bar[XB_XCNT(j)]); sum += c; cnt += (c > 0u) ? 1u : 0u; }
        mine = xb_ld(&bar[XB_XCNT(x)]);
        if (sum == G) break;
        __builtin_amdgcn_s_sleep(1);
        if ((++sp & 255u) == 0u) { if (xb_ld(&bar[XB_TMO])) break; if (sp > XB_SPIN_CAP) { atomicAdd(&bar[XB_TMO], 1u); break; } }
    }
    nloc = mine > 0u ? mine : 1u; nx = cnt > 0u ? cnt : 1u;
}
__device__ __forceinline__ void xcd_barrier(const XcdBarrier& b) {
    asm volatile("s_waitcnt vmcnt(0)" ::: "memory");
    __syncthreads();
    if (b.wave == 0 && lane_id() == 0) {
        unsigned* bar = b.bar; asm volatile("" : "+s"(bar));
        __builtin_amdgcn_s_waitcnt(0);
        unsigned nloc = b.st[0], nx = b.st[1];
        if (nloc == 0u) { xcd_barrier_complete(bar, b.x, nloc, nx); b.st[0] = nloc; b.st[1] = nx; }
        const unsigned old = xb_add(&bar[XB_XSUB(b.x)], 1u);
        const unsigned gen = old / nloc;
        if (old + 1u == (gen + 1u) * nloc) {
            __builtin_amdgcn_fence(__ATOMIC_RELEASE, "agent");
            asm volatile("s_waitcnt vmcnt(0)" ::: "memory");
            const unsigned og = xb_add(&bar[XB_TOP], 1u);
            const unsigned tg = og / nx;
            if (og + 1u == (tg + 1u) * nx) xb_add(&bar[XB_TOPGEN], 1u);
            else XB_SPIN(xb_ld(&bar[XB_TOPGEN]) == tg, bar);
            __builtin_amdgcn_fence(__ATOMIC_ACQUIRE, "agent");
            xb_add(&bar[XB_XGEN(b.x)], 1u);
            asm volatile("s_waitcnt vmcnt(0)" ::: "memory");
        } else {
            XB_SPIN(xb_ld(&bar[XB_XGEN(b.x)]) == gen, bar);
            __builtin_amdgcn_fence(__ATOMIC_ACQUIRE, "agent");
            asm volatile("s_waitcnt vmcnt(0)" ::: "memory");
        }
    }
    __syncthreads();
}

struct Args { const float* in[18]; float* out; unsigned char* ws; int ph_lo, ph_hi; };
extern __shared__ __attribute__((aligned(16))) unsigned char lds_raw[];
typedef const __attribute__((address_space(4))) Args* kargs_t;
#define KA() ({ kargs_t _p = (kargs_t)__builtin_amdgcn_kernarg_segment_ptr(); asm volatile("" : "+s"(_p)); _p; })
#define WSP(T, off) ((T*)(ka->ws + (off)))
#define INF(k) (ka->in[k])

template <int MAP> __device__ __forceinline__ int wrow_map(int n);
namespace pg8 {
constexpr int BM = 256, BK = 64, HALF = 128, HTB = HALF * BK * 2, STAGE_BYTES = 8 * HTB, NXCD = 8, WGM = 8, KK = 1024;
__host__ __device__ __forceinline__ int lds_byte(int r, int c) { const int st = (r >> 4) * 2 + (c >> 5), rr = r & 15, cc = c & 31, ob = rr * 64 + cc * 2; return st * 1024 + (ob ^ (((ob >> 9) & 1) << 5)); }
__host__ __device__ __forceinline__ void stage_rc(int b, int& R, int& C) { const int st = b / 1024, sb = b % 1024, swz = sb ^ (((sb >> 9) & 1) << 5); R = (st >> 1) * 16 + swz / 64; C = (st & 1) * 32 + (swz % 64) / 2; }
__host__ __device__ __forceinline__ int perm32(int rho) { const int n = rho >> 4, i = rho & 15; return 8 * (i >> 2) + 4 * n + (i & 3); }

struct Unit { int pm, pn, e, nvalid, mt; const char* A; const char* B; };

template <int PITCH_>
struct StaticOrderT {
    static constexpr int PITCH = PITCH_;
    int nM, nN, nwg, G, c; const char* A; const char* Bt; unsigned long long pnmap;
    __device__ void init(const void* A_, const void* Bt_, int M, int N, int G_, int c_) { A = (const char*)A_; Bt = (const char*)Bt_; nM = M / BM; nN = N / BM; nwg = nM * nN; G = G_; c = c_; pnmap = 0xFEDCBA9876543210ull; }
    __device__ void restrict_cols(unsigned long long map, int count) { pnmap = map; nN = count; nwg = nM * nN; }
    __device__ bool next(int i, Unit& u) const {
        const long L = (long)i * G + c; if (L >= nwg) return false;
        int wgid = (int)L; { const int q = nwg / NXCD, r = nwg % NXCD, xcd = wgid % NXCD, off = wgid / NXCD; wgid = (xcd < r ? xcd * (q + 1) : r * (q + 1) + (xcd - r) * q) + off; }
        const int nig = WGM * nN, gid = wgid / nig, fm = gid * WGM, gsz = (nM - fm) < WGM ? (nM - fm) : WGM;
        u.pm = fm + ((wgid % nig) % gsz); u.pn = (int)((pnmap >> (4 * ((wgid % nig) / gsz))) & 15ull); u.e = 0; u.nvalid = 256; u.mt = 0;
        u.A = A + (size_t)u.pm * (BM * PITCH); u.B = Bt + (size_t)u.pn * (BM * PITCH); return true;
    }
    __device__ __forceinline__ unsigned row_off(const Unit&, int row) const { return (unsigned)row * PITCH; }
    __device__ __forceinline__ void row_off4(const Unit&, const int (&row)[4], unsigned (&off)[4]) const {
#pragma unroll
        for (int q = 0; q < 4; ++q) off[q] = (unsigned)row[q] * PITCH; }
    __device__ __forceinline__ void list_dma(LAS unsigned char*, const Unit&, int) const {}
    __device__ __forceinline__ void row_off4_lds(LAS unsigned char*, const Unit& u, const int (&row)[4], unsigned (&off)[4]) const { row_off4(u, row, off); }
};
typedef StaticOrderT<2 * KK> StaticOrder;

template <int NTL, bool GATHER>
struct MoeOrder {
    static constexpr int PITCH = MOE_FP8 ? KK : 2 * KK;
    int MT, G, c, L; const LAS int* pre;
    __device__ bool next(int i, Unit& u) const {
        const long Lu = (long)i * G + c; int M, nt;
        if (G == 256) { const int win = (int)(Lu >> 8), w = (int)(Lu & 255), x = w & 7, j = w >> 3;
            if (NTL == 8) { M = 32 * win + 4 * x + (j >> 3); nt = j & 7; } else { M = 64 * win + 8 * x + (j >> 2); nt = j & 3; } }
        else { M = (int)(Lu / NTL); nt = (int)(Lu % NTL); }
        if (M >= MT) return false;
        const LAS int* pp = pre; asm volatile("" : "+v"(pp));
        const int e = __builtin_amdgcn_readfirstlane(pp[(MO_T2E - MO_PRE) / 4 + M]);
        const int mt = M - __builtin_amdgcn_readfirstlane(pp[e]);
        u.pm = M; u.pn = nt; u.e = e; u.mt = mt; const int left = __builtin_amdgcn_readfirstlane(pp[(MO_CNT - MO_PRE) / 4 + e]) - 256 * mt; u.nvalid = left < 256 ? left : 256;
        kargs_t ka = KA();
        const char* W = (const char*)ka->ws + (NTL == 8 ? WS_WGU : WS_WDN) + ((size_t)L * NE + e) * ((size_t)(NTL == 8 ? 2048 : 1024) * PITCH);
        u.B = W + (size_t)nt * (BM * PITCH);
        u.A = GATHER ? (const char*)ka->ws + WS_H8 : (const char*)ka->ws + WS_ACT + (size_t)M * (BM * PITCH);
        return true;
    }
    __device__ __forceinline__ unsigned row_off(const Unit& u, int row) const {
        if (!GATHER) return (unsigned)row * PITCH;
        const int rr = row < u.nvalid ? row : 0;
        kargs_t ka = KA(); const int* list = (const int*)(ka->ws + WS_LIST);
        const int ent = list[(size_t)u.e * NTOK + (size_t)u.mt * 256 + rr];
        return (unsigned)(ent >> 2) * PITCH;
    }
    __device__ __forceinline__ void list_dma(LAS unsigned char* lds, const Unit& u, int wid) const {
        if (!GATHER) return;
        if (wid == 0) { kargs_t ka = KA(); const int* lp = (const int*)(ka->ws + WS_LIST) + (size_t)u.e * NTOK + (size_t)u.mt * 256 + 4 * lane_id();
            __builtin_amdgcn_global_load_lds((const unsigned*)lp, (LAS unsigned*)(lds + MISC_OFF + MO_RF), 16, 0, 0); }
    }
    __device__ __forceinline__ void row_off4_lds(LAS unsigned char* lds, const Unit& u, const int (&row)[4], unsigned (&off)[4]) const {
        const LAS int* ll = (const LAS int*)(lds + MISC_OFF + MO_RF);
        int ent[4];
#pragma unroll
        for (int q = 0; q < 4; ++q) ent[q] = GATHER ? ll[row[q] < u.nvalid ? row[q] : 0] : 0;
#pragma unroll
        for (int q = 0; q < 4; ++q) off[q] = GATHER ? (unsigned)(ent[q] >> 2) * PITCH : (unsigned)row[q] * PITCH;
    }
    __device__ __forceinline__ void row_off4(const Unit& u, const int (&row)[4], unsigned (&off)[4]) const {
        if (!GATHER) {
#pragma unroll
            for (int q = 0; q < 4; ++q) off[q] = (unsigned)row[q] * PITCH;
            return; }
        kargs_t ka = KA(); const int* lp = (const int*)(ka->ws + WS_LIST) + (size_t)u.e * NTOK + (size_t)u.mt * 256;
        int ent[4];
#pragma unroll
        for (int q = 0; q < 4; ++q) ent[q] = lp[row[q] < u.nvalid ? row[q] : 0];
#pragma unroll
        for (int q = 0; q < 4; ++q) off[q] = (unsigned)(ent[q] >> 2) * PITCH;
    }
};

__device__ __forceinline__ unsigned cvt_pk_bf16(float lo, float hi) { return pk2(lo, hi); }

template <class Epi, class Sched, bool DYN_A, bool FP8 = false>
__device__ __forceinline__ void gemm_phase(LAS unsigned char* lds, const int wid, const Sched& S, const Epi& E, const bool dry = false) {
    const int lane = lane_id(), tid = 64 * wid + lane, wr = wid >> 2, wc = wid & 3, fr = lane & 15, fq = lane >> 4;
    constexpr int PITCH = Sched::PITCH, nt = PITCH / 128;
    static_assert(PITCH == (FP8 ? KK : 2 * KK), "operand pitch vs element type");
    unsigned voffB[2];
#pragma unroll
    for (int i = 0; i < 2; ++i) { int R, C; stage_rc(tid * 16 + i * 8192, R, C); const int Rb = Epi::PERM ? ((R & ~31) + perm32(R & 31)) : R; voffB[i] = (unsigned)(Rb * PITCH + C * 2); }
    const size_t kstep = (size_t)(BK * 2);
    const size_t hstep = (size_t)HALF * PITCH;
    const unsigned ldsw = (unsigned)wid * 1024u;
    const int aoff = lds_byte(wr * 64 + fr, fq * 8), boff = lds_byte(wc * 32 + fr, fq * 8);
#define PG8_SA(b, h) (((b) * 2 + (h)) * HTB)
#define PG8_SB(b, h) ((4 + (b) * 2 + (h)) * HTB)
#define PG8_STAGE(bufoff, gbase, voff) do { _Pragma("unroll") for (int _i = 0; _i < 2; ++_i) { unsigned o_ = (voff)[_i]; asm volatile("" : "+v"(o_));     \
        __builtin_amdgcn_global_load_lds((const unsigned*)((const char*)(gbase) + o_), (LAS unsigned*)(lds + (bufoff) + ldsw + _i * 8192), 16, 0, 0); } } while (0)
#define PG8_LDA(dst, b, h) do { _Pragma("unroll") for (int m = 0; m < 4; ++m) _Pragma("unroll") for (int k = 0; k < 2; ++k) dst[m][k] = *(const LAS bf16x8*)(lds + PG8_SA(b, h) + aoff + m * 2048 + k * 1024); } while (0)
#define PG8_LDB(dst, b, h) do { _Pragma("unroll") for (int n = 0; n < 2; ++n) _Pragma("unroll") for (int k = 0; k < 2; ++k) dst[n][k] = *(const LAS bf16x8*)(lds + PG8_SB(b, h) + boff + n * 2048 + k * 1024); } while (0)
#define PG8_AOFF_L(dst, u) do { const int t_ = 64 * wid + lane_id(); int R0_, C0_, R1_, C1_; stage_rc(t_ * 16, R0_, C0_); stage_rc(t_ * 16 + 8192, R1_, C1_); \
        const int rows_[4] = {R0_, R1_, HALF + R0_, HALF + R1_}; unsigned off_[4]; S.row_off4_lds(lds, u, rows_, off_); \
        dst[0][0] = off_[0] + (unsigned)C0_ * 2u; dst[0][1] = off_[1] + (unsigned)C1_ * 2u; dst[1][0] = off_[2] + (unsigned)C0_ * 2u; dst[1][1] = off_[3] + (unsigned)C1_ * 2u; } while (0)
#define PG8_CAT(x0, x1) __builtin_bit_cast(v8i32, __builtin_shufflevector(x0, x1, 0, 1, 2, 3, 4, 5, 6, 7, 8, 9, 10, 11, 12, 13, 14, 15))
#define PG8_MMA(ai, bj, At, Bt) do { __builtin_amdgcn_s_setprio(1); _Pragma("unroll") for (int m = 0; m < 4; ++m) _Pragma("unroll") for (int n = 0; n < 2; ++n) { \
        if (FP8) acc[ai][bj][m][n] = __builtin_amdgcn_mfma_scale_f32_16x16x128_f8f6f4(PG8_CAT(Bt[n][0], Bt[n][1]), PG8_CAT(At[m][0], At[m][1]), acc[ai][bj][m][n], 0, 0, 0, sc1_, 0, sc1_); \
        else { _Pragma("unroll") for (int k = 0; k < 2; ++k) acc[ai][bj][m][n] = __builtin_amdgcn_mfma_f32_16x16x32_bf16(Bt[n][k], At[m][k], acc[ai][bj][m][n], 0, 0, 0); } } \
        __builtin_amdgcn_s_setprio(0); } while (0)
#define PG8_WAIT_V(n) asm volatile("s_waitcnt vmcnt(" #n ")" ::: "memory")
#define PG8_WAIT_L(n) asm volatile("s_waitcnt lgkmcnt(" #n ")" ::: "memory")
#define PG8_BAR __builtin_amdgcn_s_barrier()
#define PG8_SCHED __builtin_amdgcn_sched_barrier(0)
#define PG8_AOFF(dst, u) do { const int t_ = 64 * wid + lane_id(); int R0_, C0_, R1_, C1_; stage_rc(t_ * 16, R0_, C0_); stage_rc(t_ * 16 + 8192, R1_, C1_); \
        const int rows_[4] = {R0_, R1_, HALF + R0_, HALF + R1_}; unsigned off_[4]; S.row_off4(u, rows_, off_); \
        dst[0][0] = off_[0] + (unsigned)C0_ * 2u; dst[0][1] = off_[1] + (unsigned)C1_ * 2u; dst[1][0] = off_[2] + (unsigned)C0_ * 2u; dst[1][1] = off_[3] + (unsigned)C1_ * 2u; } while (0)
    int sc1_ = 0x7f7f7f7f; asm volatile("" : "+v"(sc1_));
    Unit cur, nxt; int ui = 0;
    if (!S.next(0, cur)) return;
    f32x4 acc[2][2][4][2];
#pragma unroll
    for (int a = 0; a < 2; ++a)
#pragma unroll
        for (int b = 0; b < 2; ++b)
#pragma unroll
            for (int m = 0; m < 4; ++m)
#pragma unroll
                for (int n = 0; n < 2; ++n) acc[a][b][m][n] = (f32x4){0.f, 0.f, 0.f, 0.f};
    bf16x8 At[4][2], B0[2][2], B1[2][2];
    unsigned vA[2][2], vA2[2][2];
    PG8_AOFF(vA, cur);
#pragma unroll
    for (int h = 0; h < 2; ++h)
#pragma unroll
        for (int i = 0; i < 2; ++i) vA2[h][i] = vA[h][i];
    const char* cA = cur.A; const char* cB = cur.B;
    PG8_STAGE(PG8_SB(0, 0), cB, voffB); PG8_STAGE(PG8_SB(0, 1), cB + hstep, voffB); PG8_STAGE(PG8_SA(0, 0), cA, vA[0]); PG8_STAGE(PG8_SA(0, 1), cA, vA[1]);
    if (wr == 1) PG8_BAR;
    PG8_WAIT_V(2); PG8_BAR;
    PG8_STAGE(PG8_SB(1, 0), cB + kstep, voffB); PG8_STAGE(PG8_SA(1, 0), cA + kstep, vA[0]); PG8_STAGE(PG8_SB(1, 1), cB + hstep + kstep, voffB);
    PG8_WAIT_V(6); PG8_BAR;
    for (;;) {
        if constexpr (Epi::KHOOK) E.prep(cur, ui & 1, tid, lds);
        const bool has_next = S.next(ui + 1, nxt);
        const char* nA = has_next ? nxt.A : cA; const char* nB = has_next ? nxt.B : cB;
        if constexpr (Epi::BIAS_LDS) E.bias_dma(lds, cur, ui & 1, wid);
        if (DYN_A) { if (has_next) S.list_dma(lds, nxt, wid); }
#pragma unroll 1
        for (int t = 0; t < nt; t += 2) {
            const bool last = (t == nt - 2);
            const char* a1 = cA + (size_t)(t + 1) * kstep;
            const char* a2 = last ? nA : cA + (size_t)(t + 2) * kstep; const char* b2 = last ? nB : cB + (size_t)(t + 2) * kstep;
            const char* a3 = a2 + kstep; const char* b3 = b2 + kstep;
            if (DYN_A) { if (last && has_next) { PG8_AOFF_L(vA2, nxt); } }
            if constexpr (Epi::KHOOK) { if (t == 4 || t == 10) E.khook(acc, cur, t, wr, lane_id(), ui & 1, lds); }
            PG8_LDB(B0, 0, 0); PG8_LDB(B1, 0, 1); PG8_SCHED; PG8_LDA(At, 0, 0); PG8_STAGE(PG8_SA(1, 1), a1, vA[1]);
            PG8_WAIT_V(8); PG8_WAIT_L(0); PG8_BAR; PG8_MMA(0, 0, At, B0); PG8_MMA(0, 1, At, B1); PG8_BAR; PG8_SCHED;
            PG8_LDA(At, 0, 1); PG8_STAGE(PG8_SB(0, 0), b2, voffB); PG8_STAGE(PG8_SB(0, 1), b2 + hstep, voffB); PG8_STAGE(PG8_SA(0, 0), a2, vA2[0]);
            PG8_WAIT_V(8); PG8_WAIT_L(0); PG8_BAR; PG8_MMA(1, 0, At, B0); PG8_MMA(1, 1, At, B1); PG8_BAR; PG8_SCHED;
            PG8_LDB(B0, 1, 0); PG8_LDB(B1, 1, 1); PG8_SCHED; PG8_LDA(At, 1, 0); PG8_STAGE(PG8_SA(0, 1), a2, vA2[1]);
            PG8_WAIT_V(8); PG8_WAIT_L(0); PG8_BAR; PG8_MMA(0, 0, At, B0); PG8_MMA(0, 1, At, B1); PG8_BAR; PG8_SCHED;
            PG8_LDA(At, 1, 1); PG8_STAGE(PG8_SB(1, 0), b3, voffB); PG8_STAGE(PG8_SB(1, 1), b3 + hstep, voffB); PG8_STAGE(PG8_SA(1, 0), a3, vA2[0]);
            PG8_WAIT_V(8); PG8_WAIT_L(0); PG8_BAR; PG8_MMA(1, 0, At, B0); PG8_MMA(1, 1, At, B1); PG8_BAR; PG8_SCHED;
        }
        if (wr == 0) PG8_BAR;
        if constexpr (Epi::KHOOK) { if (!dry) E.fin(acc, cur, wr, wc, lane_id(), ui & 1, lds); }
        else if (!dry) { if constexpr (Epi::BIAS_LDS) E(acc, cur, wr, wc, lane_id(), ui, lds); else E(acc, cur, wr, wc, lane_id()); }
        else { float sink = 0.f;
#pragma unroll
            for (int a = 0; a < 2; ++a)
#pragma unroll
                for (int b = 0; b < 2; ++b)
#pragma unroll
                    for (int m = 0; m < 4; ++m)
#pragma unroll
                        for (int n = 0; n < 2; ++n) sink += acc[a][b][m][n][0] + acc[a][b][m][n][1] + acc[a][b][m][n][2] + acc[a][b][m][n][3];
            asm volatile("" :: "v"(sink)); }
        if (!has_next) break;
#pragma unroll
        for (int a = 0; a < 2; ++a)
#pragma unroll
            for (int b = 0; b < 2; ++b)
#pragma unroll
                for (int m = 0; m < 4; ++m)
#pragma unroll
                    for (int n = 0; n < 2; ++n) acc[a][b][m][n] = (f32x4){0.f, 0.f, 0.f, 0.f};
        cur = nxt; cA = nA; cB = nB; ++ui;
#pragma unroll
        for (int h = 0; h < 2; ++h)
#pragma unroll
            for (int i = 0; i < 2; ++i) vA[h][i] = vA2[h][i];
        if (wr == 1) PG8_BAR;
    }
    PG8_WAIT_V(0);
    PG8_BAR;
#undef PG8_SA
#undef PG8_SB
#undef PG8_STAGE
#undef PG8_LDA
#undef PG8_LDB
#undef PG8_MMA
#undef PG8_WAIT_V
#undef PG8_WAIT_L
#undef PG8_BAR
#undef PG8_SCHED
#undef PG8_AOFF
#undef PG8_AOFF_L
#undef PG8_CAT
}

struct EpiQKV {
    static constexpr bool PERM = true, KHOOK = false, BIAS_LDS = false;
    bf16_t* Qo; const float* rope; float wsc;
    __device__ __forceinline__ void operator()(const f32x4 (&acc)[2][2][4][2], const Unit& u, int wr, int wc, int ln_) const {
        const int fr = ln_ & 15, fq = (ln_ >> 4) & 3;
        const int region = u.pn >> 2, tcol = (u.pn & 3) * 256;
        bf16_t* base = Qo + (size_t)region * ((WS_K - WS_Q) / 2);
        const float sc = (region == 0 ? QSCALE : 1.0f) * wsc;
#pragma unroll
        for (int bj = 0; bj < 2; ++bj) {
            const int cg = tcol + 128 * bj + 32 * wc, head = cg >> 6;
            const bool rope_on = (region < 2) && (head >= 4) && (head < 10);
            if (!rope_on) {
#pragma unroll
                for (int ai = 0; ai < 2; ++ai)
#pragma unroll
                    for (int m = 0; m < 4; ++m) { const size_t row = (size_t)u.pm * BM + ai * HALF + wr * 64 + m * 16 + fr;
                        const f32x4 v0 = acc[ai][bj][m][0] * sc, v1 = acc[ai][bj][m][1] * sc; u32x4 w;
                        w.x = pk2(v0[0], v0[1]); w.y = pk2(v0[2], v0[3]); w.z = pk2(v1[0], v1[1]); w.w = pk2(v1[2], v1[3]);
                        *(u32x4*)(base + row * DM + cg + 8 * fq) = w; }
            } else {
                const int j0 = 16 * ((cg >> 5) & 1) + 4 * fq;
#pragma unroll
                for (int ai = 0; ai < 2; ++ai)
#pragma unroll
                    for (int m = 0; m < 4; ++m) { const size_t row = (size_t)u.pm * BM + ai * HALF + wr * 64 + m * 16 + fr;
                        const f32x4 v0 = acc[ai][bj][m][0] * sc, v1 = acc[ai][bj][m][1] * sc;
                        const f32x4 cs0 = *(const f32x4*)(rope + row * 64 + 2 * j0), cs1 = *(const f32x4*)(rope + row * 64 + 2 * j0 + 4);
                        const float a0 = v0[0] * cs0[0] - v0[1] * cs0[1], b0 = v0[1] * cs0[0] + v0[0] * cs0[1];
                        const float a1 = v0[2] * cs0[2] - v0[3] * cs0[3], b1 = v0[3] * cs0[2] + v0[2] * cs0[3];
                        const float a2 = v1[0] * cs1[0] - v1[1] * cs1[1], b2 = v1[1] * cs1[0] + v1[0] * cs1[1];
                        const float a3 = v1[2] * cs1[2] - v1[3] * cs1[3], b3 = v1[3] * cs1[2] + v1[2] * cs1[3];
                        u32x2 wa, wb; wa.x = pk2(a0, a1); wa.y = pk2(a2, a3); wb.x = pk2(b0, b1); wb.y = pk2(b2, b3);
                        bf16_t* rp = base + row * DM + head * 64 + j0;
                        *(u32x2*)rp = wa; *(u32x2*)(rp + 32) = wb; }
            }
        }
    }
};
struct EpiOut {
    static constexpr bool PERM = true, KHOOK = (FUSE_ONORM != 0), BIAS_LDS = false;
    const float* base32; const bf16_t* base16; bf16_t* out16; const float* ga; const float* ss;
    __device__ __forceinline__ void prep(const Unit& u, int par, int tid, LAS unsigned char* lds) const {
        if (tid < 256) { const f32x4* sp = (const f32x4*)(ss + 16 * ((size_t)u.pm * BM + tid)); const f32x4 a = sp[0], b = sp[1], c = sp[2], d = sp[3];
            const float s0 = (a[0] + a[1]) + (a[2] + a[3]), s1 = ((b[0] + b[1]) + (b[2] + b[3])) + (c[0] + c[1]), s2 = (c[2] + c[3]) + ((d[0] + d[1]) + (d[2] + d[3]));
            const float r0 = frsq(s0 * (1.0f / 256) + EPS), r1 = frsq(s1 * (1.0f / 384) + EPS), r2 = frsq(s2 * (1.0f / 384) + EPS);
            *(LAS f32x4*)(lds + MISC_OFF + MO_RF + par * 4096 + tid * 16) = (f32x4){r0 * frcp(r1), r1 * frcp(r2), r2, 0.f}; }
    }
    __device__ __forceinline__ void khook(f32x4 (&acc)[2][2][4][2], const Unit& u, int t, int wr, int ln_, int par, LAS unsigned char* lds) const {
        const int fr = ln_ & 15, gp = (t == 4) ? 0 : 1;
#pragma unroll
        for (int ai = 0; ai < 2; ++ai)
#pragma unroll
            for (int m = 0; m < 4; ++m) { const int r = ai * HALF + wr * 64 + m * 16 + fr; const float f = *(const LAS float*)(lds + MISC_OFF + MO_RF + par * 4096 + r * 16 + 4 * gp);
#pragma unroll
                for (int bj = 0; bj < 2; ++bj)
#pragma unroll
                    for (int n = 0; n < 2; ++n) acc[ai][bj][m][n] = acc[ai][bj][m][n] * f; }
    }
    __device__ __forceinline__ void fin(const f32x4 (&acc)[2][2][4][2], const Unit& u, int wr, int wc, int ln_, int par, LAS unsigned char* lds) const {
        const int fr = ln_ & 15, fq = (ln_ >> 4) & 3;
        const int b = (u.pm * BM) / SEQ; const float* gab = ga + (size_t)b * (NMOD * DM);
        float r2[2][4];
#pragma unroll
        for (int ai = 0; ai < 2; ++ai)
#pragma unroll
            for (int m = 0; m < 4; ++m) r2[ai][m] = FUSE_ONORM ? *(const LAS float*)(lds + MISC_OFF + MO_RF + par * 4096 + (ai * HALF + wr * 64 + m * 16 + fr) * 16 + 8) : 1.0f;
#pragma unroll
        for (int bj = 0; bj < 2; ++bj) { const int col = u.pn * BM + bj * HALF + wc * 32 + 8 * fq; const f32x4 g0 = *(const f32x4*)(gab + col), g1 = *(const f32x4*)(gab + col + 4);
#pragma unroll
            for (int ai = 0; ai < 2; ++ai)
#pragma unroll
                for (int m = 0; m < 4; ++m) { const size_t off = ((size_t)u.pm * BM + ai * HALF + wr * 64 + m * 16 + fr) * DM + col; f32x4 b0, b1;
                    if (base32) { b0 = *(const f32x4*)(base32 + off); b1 = *(const f32x4*)(base32 + off + 4); }
                    else { const u32x4 w = *(const u32x4*)(base16 + off); b0 = (f32x4){bf_lo(w.x), bf_hi(w.x), bf_lo(w.y), bf_hi(w.y)}; b1 = (f32x4){bf_lo(w.z), bf_hi(w.z), bf_lo(w.w), bf_hi(w.w)}; }
                    const f32x4 o0 = b0 + (g0 * r2[ai][m]) * acc[ai][bj][m][0], o1 = b1 + (g1 * r2[ai][m]) * acc[ai][bj][m][1];
                    u32x4 w; w.x = pk2(o0[0], o0[1]); w.y = pk2(o0[2], o0[3]); w.z = pk2(o1[0], o1[1]); w.w = pk2(o1[2], o1[3]);
                    *(u32x4*)(out16 + off) = w; } }
    }
    __device__ __forceinline__ void operator()(const f32x4 (&acc)[2][2][4][2], const Unit& u, int wr, int wc, int ln_) const { fin(acc, u, wr, wc, ln_, 0, nullptr); }
};
struct EpiGU {
    static constexpr bool PERM = true, KHOOK = false, BIAS_LDS = true;
    int L;
    __device__ __forceinline__ void bias_dma(LAS unsigned char* lds, const Unit& u, int par, int wid) const {
        if (wid == 0) { const int ln = lane_id(); kargs_t ka = KA(); const float* bgu = ka->in[14] + (size_t)L * NE * 2048;
            const float* p = bgu + (size_t)u.e * 2048 + 128 * u.pn + (ln < 32 ? 4 * ln : 1024 + 4 * (ln - 32));
            __builtin_amdgcn_global_load_lds((const unsigned*)p, (LAS unsigned*)(lds + MISC_OFF + MO_RF + 2048 + par * 1024), 16, 0, 0); }
    }
    __device__ __forceinline__ void operator()(const f32x4 (&acc)[2][2][4][2], const Unit& u, int wr, int wc, int ln_, int ui_, LAS unsigned char* lds) const {
        const int par = ui_ & 1;
        const int fr = ln_ & 15, fq = (ln_ >> 4) & 3;
        kargs_t ka = KA(); unsigned char* act = ka->ws + WS_ACT;
        int blk_ = blockIdx.x; asm volatile("" : "+s"(blk_));
        const int cvi = (ui_ * 256 + blk_) * 8 + wr * 4 + wc;
        const bool cv = EPI_CONV && (L + 1 < DEPTH) && (cvi < 16384) && (gridDim.x == 256);
        f32x4 cvv[16]; const float* cvs = nullptr; unsigned char* cvd = nullptr; int cvn = 0, cvld = 0, cvgu = 0;
        if (cv) { const int g = ln_ >> 3, cq = ln_ & 7; int r = cvi;
            if (r < 16384) { const int e = r / 512, q = r % 512, k0 = 128 * (q / 64), n0 = 32 * (q % 64); cvld = 2048; cvgu = 1; cvn = n0 + 4 * cq;
                cvs = ka->in[13] + ((size_t)(L + 1) * NE + e) * DM * 2048 + (size_t)(k0 + 16 * g) * 2048 + n0 + 4 * cq; cvd = ka->ws + WS_WGU + ((size_t)(L + 1) * NE + e) * 2048 * DM + k0 + 16 * g; }
            else { r -= 16384; const int e = r / 256, q = r % 256, k0 = 128 * (q / 32), n0 = 32 * (q % 32); cvld = DM; cvgu = 0; cvn = n0 + 4 * cq;
                cvs = ka->in[15] + ((size_t)(L + 1) * NE + e) * DM * DM + (size_t)(k0 + 16 * g) * DM + n0 + 4 * cq; cvd = ka->ws + WS_WDN + ((size_t)(L + 1) * NE + e) * DM * DM + k0 + 16 * g; }
#pragma unroll
            for (int i = 0; i < 16; ++i) cvv[i] = *(const f32x4u*)(cvs + (size_t)i * cvld);
        } else {
#pragma unroll
            for (int i = 0; i < 16; ++i) cvv[i] = (f32x4){0.f, 0.f, 0.f, 0.f};
        }
        const int jl = 128 * u.pn + 32 * wc + 8 * fq; const LAS float* bb = (const LAS float*)(lds + MISC_OFF + MO_RF + 2048 + par * 1024) + 32 * wc + 8 * fq;
        const f32x4 bg0 = *(const LAS f32x4*)(bb), bg1 = *(const LAS f32x4*)(bb + 4), bu0p = *(const LAS f32x4*)(bb + 128) + 1.0f, bu1p = *(const LAS f32x4*)(bb + 132) + 1.0f;
#pragma unroll
        for (int ai = 0; ai < 2; ++ai)
#pragma unroll
            for (int m = 0; m < 4; ++m) { const size_t row = (size_t)u.pm * BM + ai * HALF + wr * 64 + m * 16 + fr;
                float o[8];
#pragma unroll
                for (int n = 0; n < 2; ++n) { const float ws_ = MOE_FP8 ? (1.0f / 32.0f) : 1.0f; const f32x4 gv = acc[ai][0][m][n] * ws_ + (n ? bg1 : bg0), uv1 = acc[ai][1][m][n] * ws_ + (n ? bu1p : bu0p);
#pragma unroll
                    for (int i = 0; i < 4; ++i) { const float g = fminf(gv[i], 7.0f), up1 = fminf(fmaxf(uv1[i], -6.0f), 8.0f);
                        const float sg = frcp(1.0f + fexp2(-1.702f * LOG2E * g)); o[4 * n + i] = up1 * (g * sg); } }
                if (MOE_FP8) { u32x2 w; w.x = pk4_fp8(o[0], o[1], o[2], o[3]); w.y = pk4_fp8(o[4], o[5], o[6], o[7]); *(u32x2*)(act + row * DM + jl) = w; }
                else { u32x4 w; w.x = pk2(o[0], o[1]); w.y = pk2(o[2], o[3]); w.z = pk2(o[4], o[5]); w.w = pk2(o[6], o[7]); *(u32x4*)((bf16_t*)act + row * DM + jl) = w; } }
        if (cv) {
#pragma unroll
            for (int c = 0; c < 4; ++c) { const int n_ = cvn + c; const int prow = cvgu ? ::wrow_map<2>(n_) : ::wrow_map<3>(n_); u32x4 a;
                a.x = pk4_fp8(cvv[0][c] * 32.0f, cvv[1][c] * 32.0f, cvv[2][c] * 32.0f, cvv[3][c] * 32.0f); a.y = pk4_fp8(cvv[4][c] * 32.0f, cvv[5][c] * 32.0f, cvv[6][c] * 32.0f, cvv[7][c] * 32.0f);
                a.z = pk4_fp8(cvv[8][c] * 32.0f, cvv[9][c] * 32.0f, cvv[10][c] * 32.0f, cvv[11][c] * 32.0f); a.w = pk4_fp8(cvv[12][c] * 32.0f, cvv[13][c] * 32.0f, cvv[14][c] * 32.0f, cvv[15][c] * 32.0f);
                *(u32x4*)(cvd + (size_t)prow * DM) = a; }
        }
    }
};
struct EpiDN {
    static constexpr bool PERM = true, KHOOK = false, BIAS_LDS = true;
    int L;
    __device__ __forceinline__ void bias_dma(LAS unsigned char* lds, const Unit& u, int par, int wid) const {
        if (wid == 0) { kargs_t ka = KA(); const float* p = ka->in[16] + (size_t)L * NE * DM + (size_t)u.e * DM + u.pn * BM + 4 * lane_id();
            __builtin_amdgcn_global_load_lds((const unsigned*)p, (LAS unsigned*)(lds + MISC_OFF + MO_RF + 2048 + par * 1024), 16, 0, 0); }
    }
    __device__ __forceinline__ void operator()(const f32x4 (&acc)[2][2][4][2], const Unit& u, int wr, int wc, int ln_, int ui_, LAS unsigned char* lds) const {
        const int par = ui_ & 1;
        const int fr = ln_ & 15, fq = (ln_ >> 4) & 3;
        kargs_t ka = KA(); bf16_t* outb = (bf16_t*)(ka->ws + WS_OUTB); const float* bdn = ka->in[16] + (size_t)L * NE * DM; const int* list = (const int*)(ka->ws + WS_LIST); const float* topg = (const float*)(ka->ws + WS_TOPG);
        const int* lp = list + (size_t)u.e * NTOK + (size_t)u.mt * 256;
        f32x4 bv[2][2];
#pragma unroll
        for (int bj = 0; bj < 2; ++bj)
#pragma unroll
            for (int n = 0; n < 2; ++n) bv[bj][n] = *(const LAS f32x4*)((const LAS float*)(lds + MISC_OFF + MO_RF + 2048 + par * 1024) + 64 * wc + 16 * fq + 8 * bj + 4 * n);
        f32x4 bv16[2][2];
#pragma unroll
        for (int bj = 0; bj < 2; ++bj)
#pragma unroll
            for (int n = 0; n < 2; ++n) bv16[bj][n] = bv[bj][n] * 16.0f;
        if (SLOT_OUT && OUT_FP8) {
            unsigned char* ob = (unsigned char*)outb;
#pragma unroll
            for (int ai = 0; ai < 2; ++ai)
#pragma unroll
                for (int m = 0; m < 4; ++m) { const size_t row = (size_t)u.pm * BM + ai * HALF + wr * 64 + m * 16 + fr; u32x4 w16;
#pragma unroll
                    for (int bj = 0; bj < 2; ++bj) { const float ws16 = (MOE_FP8 ? (1.0f / 32.0f) : 1.0f) * 16.0f;
                        const f32x4 q0 = acc[ai][bj][m][0] * ws16 + bv16[bj][0], q1 = acc[ai][bj][m][1] * ws16 + bv16[bj][1]; f32x4 c0, c1;
#pragma unroll
                        for (int i = 0; i < 4; ++i) { c0[i] = fminf(fmaxf(q0[i], -448.0f), 448.0f); c1[i] = fminf(fmaxf(q1[i], -448.0f), 448.0f); }
                        const unsigned lo = pk4_fp8(c0[0], c0[1], c0[2], c0[3]), hi = pk4_fp8(c1[0], c1[1], c1[2], c1[3]);
                        if (bj == 0) { w16.x = lo; w16.y = hi; } else { w16.z = lo; w16.w = hi; } }
                    *(u32x4*)(ob + row * DM + u.pn * BM + 64 * wc + 16 * fq) = w16; }
            return; }
        static_assert(SLOT_OUT && OUT_FP8 && MOE_FP8, "the other output paths assume the unpermuted w_dn row order");
#pragma unroll
        for (int ai = 0; ai < 2; ++ai)
#pragma unroll
            for (int m = 0; m < 4; ++m) { const int r = ai * HALF + wr * 64 + m * 16 + fr;
                if (r < u.nvalid) { const int ent = lp[r]; const float gw = topg[ent]; bf16_t* rp = outb + (size_t)ent * DM + u.pn * BM + wc * 32 + 8 * fq;
#pragma unroll
                    for (int bj = 0; bj < 2; ++bj) { const float ws_ = MOE_FP8 ? (1.0f / 32.0f) : 1.0f;
                        if (OUT_FP8) { const f32x4 q0 = (acc[ai][bj][m][0] * ws_ + bv[bj][0]) * (gw * 16.0f), q1 = (acc[ai][bj][m][1] * ws_ + bv[bj][1]) * (gw * 16.0f);
                            f32x4 c0, c1;
#pragma unroll
                            for (int i = 0; i < 4; ++i) { c0[i] = fminf(fmaxf(q0[i], -448.0f), 448.0f); c1[i] = fminf(fmaxf(q1[i], -448.0f), 448.0f); }
                            u32x2 w8; w8.x = pk4_fp8(c0[0], c0[1], c0[2], c0[3]); w8.y = pk4_fp8(c1[0], c1[1], c1[2], c1[3]);
                            *(u32x2*)((unsigned char*)outb + (size_t)ent * DM + u.pn * BM + wc * 32 + 8 * fq + bj * HALF) = w8; continue; } const f32x4 v0 = (acc[ai][bj][m][0] * ws_ + bv[bj][0]) * gw, v1 = (acc[ai][bj][m][1] * ws_ + bv[bj][1]) * gw; u32x4 w;
                        w.x = pk2(v0[0], v0[1]); w.y = pk2(v0[2], v0[3]); w.z = pk2(v1[0], v1[1]); w.w = pk2(v1[2], v1[3]);
                        *(u32x4*)(rp + bj * HALF) = w; } } }
    }
};
}

namespace att {
constexpr int OFF_K = 0, OFF_V = 32768, OFF_BIAS = 65536;
__device__ __forceinline__ int crow(int r, int hi) { return (r & 3) + 8 * (r >> 2) + 4 * hi; }
__device__ __forceinline__ float max3f(float a, float b, float c) { float r; asm("v_max3_f32 %0, %1, %2, %3" : "=v"(r) : "v"(a), "v"(b), "v"(c)); return r; }

template <int TYPE>
__device__ __forceinline__ void attn_unit(LAS unsigned char* lds, volatile LAS int* misc, const bf16_t* __restrict__ Q, const bf16_t* __restrict__ Kg, const bf16_t* __restrict__ Vg, bf16_t* __restrict__ O,
                                          const float* __restrict__ lf2, float* __restrict__ ssrow, int b, int head, int qb, const int tid, gu32* qhead) {
    const int wid = __builtin_amdgcn_readfirstlane(tid >> 6), lane = tid & 63, r32 = lane & 31, hh = lane >> 5;
    const int tq = 256 * qb + 32 * wid + r32;
    const size_t grow = (size_t)b * SEQ + tq;
    const int qlo = 256 * qb + 32 * wid, qhi = qlo + 31;
    LAS float* bias = (LAS float*)(lds + OFF_BIAS);
    bf16x8 qf[4];
#pragma unroll
    for (int s = 0; s < 4; ++s) qf[s] = *(const bf16x8*)(Q + grow * DM + head * 64 + 16 * s + 8 * hh);
    float lbn[16];
    if (TYPE == 1) {
#pragma unroll
        for (int r = 0; r < 16; ++r) { const int c = (tq - crow(r, hh)) & 15; const bool m16 = (c == 0), m4 = ((c & 3) == 0);
            lbn[r] = m16 ? 1.5849625007211562f : (m4 ? 1.0f : 0.0f); }
    }
#define LB_MID(v) ((v) > 1.25f ? 1.0f : ((v) > 0.5f ? 0.0f : -INFINITY))
#define LB_FAR(v) ((v) > 1.25f ? 0.0f : -INFINITY)
    const int skv = tid >> 3, sch = tid & 7;
    const unsigned kst = 128u * skv + ((unsigned)(sch ^ ((skv >> 1) & 7)) << 4);
    const unsigned vst = 128u * skv + (((unsigned)sch << 4) ^ (((unsigned)(skv >> 1) & 1u) << 6));
    const bf16_t* kgp = Kg + ((size_t)b * SEQ + skv) * DM + head * 64 + 8 * sch;
    const bf16_t* vgp = Vg + ((size_t)b * SEQ + skv) * DM + head * 64 + 8 * sch;
    const unsigned krd0 = 128u * r32, krd1 = 128u * (r32 + 32);
    const int ksw0 = (r32 >> 1) & 7, ksw1 = ((r32 + 32) >> 1) & 7;
    const int g4 = lane >> 4, q4 = (lane >> 2) & 3, p4 = lane & 3;
    unsigned vrd[2][2];
#pragma unroll
    for (int e = 0; e < 2; ++e)
#pragma unroll
        for (int db = 0; db < 2; ++db) { const int row = 8 * e + 4 * hh + q4; const unsigned bytec = (unsigned)(32 * db + 16 * (g4 & 1) + 4 * p4) * 2u;
            vrd[e][db] = 128u * row + (bytec ^ (((unsigned)(row >> 1) & 1u) << 6)); }

    f32x16 oT[2];
#pragma unroll
    for (int d = 0; d < 2; ++d)
#pragma unroll
        for (int r = 0; r < 16; ++r) oT[d][r] = 0.f;
    float mrun = -1e30f, lrun = 0.f, Rrun = 0.f;

    const int jt_hi = 4 * qb + 3;
    u32x4 kreg0 = *(const u32x4*)(kgp + (size_t)(64 * jt_hi) * DM), vreg0 = *(const u32x4*)(vgp + (size_t)(64 * jt_hi) * DM);
    u32x4 kreg1 = *(const u32x4*)(kgp + (size_t)(64 * (jt_hi - 1)) * DM), vreg1 = *(const u32x4*)(vgp + (size_t)(64 * (jt_hi - 1)) * DM);
    if (TYPE == 2) {
        const int n = 256 * (qb + 1), i4 = tid * 4;
        f32x4 v = (f32x4){0.f, 0.f, 0.f, 0.f};
        if (i4 < n) v = *(const f32x4*)(lf2 + i4);
        v[1] += v[0]; v[2] += v[1]; v[3] += v[2];
        float tot = v[3], inc = tot;
#pragma unroll
        for (int o = 1; o < 64; o <<= 1) { const float t = __builtin_bit_cast(float, __builtin_amdgcn_ds_bpermute((lane - o) << 2, __builtin_bit_cast(int, inc))); if (lane >= o) inc += t; }
        LAS float* sc = (LAS float*)(misc + (MO_SCAN / 4));
        if (lane == 63) sc[wid] = inc;
        __syncthreads();
        float woff = 0.f;
#pragma unroll
        for (int w = 0; w < 8; ++w) woff += (w < wid) ? sc[w] : 0.f;
        const float ex = woff + inc - tot;
        *(LAS f32x4*)(bias + i4) = (f32x4){ex + v[0], ex + v[1], ex + v[2], ex + v[3]};
        __syncthreads();
        const float cref = bias[n - 1];
        __syncthreads();
        f32x4 c4 = *(LAS f32x4*)(bias + i4); c4 = cref - c4; *(LAS f32x4*)(bias + i4) = c4;
    }
    if (tid == 0) misc[MO_Q / 4] = (int)__hip_atomic_fetch_add(qhead, 1u, __ATOMIC_RELAXED, __HIP_MEMORY_SCOPE_AGENT);
    bool stop = false, wdone = false;
    for (int P = jt_hi >> 1; P >= 0 && !stop; --P) {
        const int pb_ = (P & 1) * 16384;
        *(LAS u32x4*)(lds + OFF_K + pb_ + 8192 + kst) = kreg0; *(LAS u32x4*)(lds + OFF_V + pb_ + 8192 + vst) = vreg0;
        *(LAS u32x4*)(lds + OFF_K + pb_ + kst) = kreg1; *(LAS u32x4*)(lds + OFF_V + pb_ + vst) = vreg1;
        __syncthreads();
        if (TYPE == 0) { if (P < (jt_hi >> 1)) { bool alld = true;
#pragma unroll
                for (int w = 0; w < 8; ++w) alld = alld && (misc[(MO_VOTE / 4) + ((P + 1) & 1) * 8 + w] != 0);
                if (alld) break; } }
        if (P > 0) { kreg0 = *(const u32x4*)(kgp + (size_t)(64 * (2 * P - 1)) * DM); vreg0 = *(const u32x4*)(vgp + (size_t)(64 * (2 * P - 1)) * DM);
                     kreg1 = *(const u32x4*)(kgp + (size_t)(64 * (2 * P - 2)) * DM); vreg1 = *(const u32x4*)(vgp + (size_t)(64 * (2 * P - 2)) * DM); }
#pragma unroll 1
        for (int sub = 1; sub >= 0; --sub) {
        const int jt = 2 * P + sub; const int buf = 0; (void)buf;
        const int kv0 = 64 * jt;
        const bool active = (kv0 <= qhi) && !(TYPE == 0 && (kv0 >= qhi || wdone));
        if (active) {
            const LAS unsigned char* Kb = lds + OFF_K + pb_ + sub * 8192; const LAS unsigned char* Vb = lds + OFF_V + pb_ + sub * 8192;
            f32x16 p0, p1; bool negl = false;
            const bool full = (kv0 + 63 <= qlo);
            if (TYPE == 2) {
#pragma unroll
                for (int g = 0; g < 4; ++g) { const f32x4 b0 = *(const LAS f32x4*)(bias + kv0 + 8 * g + 4 * hh), b1 = *(const LAS f32x4*)(bias + kv0 + 32 + 8 * g + 4 * hh);
#pragma unroll
                    for (int j = 0; j < 4; ++j) { p0[4 * g + j] = b0[j]; p1[4 * g + j] = b1[j]; } }
            } else {
#pragma unroll
                for (int r = 0; r < 16; ++r) { p0[r] = 0.f; p1[r] = 0.f; }
            }
            bf16x8 kfa[4], kfb[4];
#pragma unroll
            for (int s = 0; s < 4; ++s) {
                kfa[s] = *(const LAS bf16x8*)(Kb + krd0 + (((2 * s + hh) ^ ksw0) << 4));
                kfb[s] = *(const LAS bf16x8*)(Kb + krd1 + (((2 * s + hh) ^ ksw1) << 4));
            }
            __builtin_amdgcn_sched_barrier(0);
#pragma unroll
            for (int s = 0; s < 4; ++s) {
                p0 = __builtin_amdgcn_mfma_f32_32x32x16_bf16(kfa[s], qf[s], p0, 0, 0, 0);
                p1 = __builtin_amdgcn_mfma_f32_32x32x16_bf16(kfb[s], qf[s], p1, 0, 0, 0);
            }
            if (TYPE == 0) {
                float x0[16], x1[16];
#pragma unroll
                for (int r = 0; r < 16; ++r) {
                    const float z0 = p0[r], z1 = p1[r];
                    float n0 = fminf(-z0, 0.f) - flog2(1.0f + fexp2(-fabsf(z0)));
                    float n1 = fminf(-z1, 0.f) - flog2(1.0f + fexp2(-fabsf(z1)));
                    if (!full) { const int kvp = kv0 + crow(r, hh); if (kvp >= tq) n0 = 0.f; if (kvp + 32 >= tq) n1 = 0.f; }
                    x0[r] = n0; x1[r] = n1; p0[r] = z0 + n0; p1[r] = z1 + n1;
                }
                float T[8], PGm[8];
#pragma unroll
                for (int g = 0; g < 4; ++g) { const float ga = (x0[4 * g] + x0[4 * g + 1]) + (x0[4 * g + 2] + x0[4 * g + 3]), gb = (x1[4 * g] + x1[4 * g + 1]) + (x1[4 * g + 2] + x1[4 * g + 3]);
                    const float pa = xhalf_get(ga, lane), pb2 = xhalf_get(gb, lane); T[g] = ga + pa; T[4 + g] = gb + pb2; PGm[g] = hh == 0 ? pa : 0.f; PGm[4 + g] = hh == 0 ? pb2 : 0.f; }
                float run = 0.f;
#pragma unroll
                for (int g = 7; g >= 0; --g) { const float lg = Rrun + run + PGm[g]; run += T[g]; T[g] = lg; }
                Rrun += run;
#pragma unroll
                for (int g = 0; g < 4; ++g) {
                    { const float b3 = T[g], b2 = b3 + x0[4 * g + 3], b1 = b2 + x0[4 * g + 2], b0 = b1 + x0[4 * g + 1];
                      p0[4 * g + 3] = fexp2(p0[4 * g + 3] + b3); p0[4 * g + 2] = fexp2(p0[4 * g + 2] + b2); p0[4 * g + 1] = fexp2(p0[4 * g + 1] + b1); p0[4 * g] = fexp2(p0[4 * g] + b0); }
                    { const float b3 = T[4 + g], b2 = b3 + x1[4 * g + 3], b1 = b2 + x1[4 * g + 2], b0 = b1 + x1[4 * g + 1];
                      p1[4 * g + 3] = fexp2(p1[4 * g + 3] + b3); p1[4 * g + 2] = fexp2(p1[4 * g + 2] + b2); p1[4 * g + 1] = fexp2(p1[4 * g + 1] + b1); p1[4 * g] = fexp2(p1[4 * g] + b0); }
                }
                if (!full) {
#pragma unroll
                    for (int r = 0; r < 16; ++r) { const int kvp = kv0 + crow(r, hh); if (kvp >= tq) p0[r] = 0.f; if (kvp + 32 >= tq) p1[r] = 0.f; }
                }
            } else {
                if (TYPE == 1) {
                const int dmin = qlo - (kv0 + 63), dmax = qhi - kv0;
                if (dmin > 512) {
#pragma unroll
                    for (int r = 0; r < 16; ++r) { const float c = LB_FAR(lbn[r]); p0[r] += c; p1[r] += c; }
                } else if (dmin > 128 && dmax <= 512) {
#pragma unroll
                    for (int r = 0; r < 16; ++r) { const float c = LB_MID(lbn[r]); p0[r] += c; p1[r] += c; }
                } else if (dmin >= 0 && dmax <= 128) {
#pragma unroll
                    for (int r = 0; r < 16; ++r) { p0[r] += lbn[r]; p1[r] += lbn[r]; }
                } else {
#pragma unroll
                    for (int r = 0; r < 16; ++r) { const int d0 = tq - (kv0 + crow(r, hh)), d1 = d0 - 32; const float vn = lbn[r], vm = LB_MID(vn), vf = LB_FAR(vn);
                        p0[r] += d0 < 0 ? -INFINITY : (d0 <= 128 ? vn : (d0 <= 512 ? vm : vf));
                        p1[r] += d1 < 0 ? -INFINITY : (d1 <= 128 ? vn : (d1 <= 512 ? vm : vf)); }
                }
                }
                if (TYPE == 2 && !full) {
#pragma unroll
                    for (int r = 0; r < 16; ++r) { const int kvp = kv0 + crow(r, hh); if (kvp > tq) p0[r] = -INFINITY; if (kvp + 32 > tq) p1[r] = -INFINITY; }
                }
                float mxa = max3f(p0[0], p0[1], p0[2]), mxb = max3f(p1[0], p1[1], p1[2]);
#pragma unroll
                for (int r = 3; r < 15; r += 2) { mxa = max3f(mxa, p0[r], p0[r + 1]); mxb = max3f(mxb, p1[r], p1[r + 1]); }
                float mx = max3f(mxa, mxb, fmaxf(p0[15], p1[15]));
                negl = (TYPE == 2) && __all(mx < mrun - 40.0f);
                if (!negl) {
                if (__any(mx > mrun + 8.0f)) {
                    mx = fmaxf(mx, xhalf_get(mx, lane));
                    const float mnew = (mx > mrun + 8.0f) ? mx : mrun, alpha = fexp2(mrun - mnew); mrun = mnew;
                    lrun = lrun * alpha;
#pragma unroll
                    for (int d = 0; d < 2; ++d)
#pragma unroll
                        for (int r = 0; r < 16; ++r) oT[d][r] *= alpha;
                }
#pragma unroll
                for (int r = 0; r < 16; ++r) { p0[r] = fexp2(p0[r] - mrun); p1[r] = fexp2(p1[r] - mrun); }
                }
            }
            if (!negl) {
            bf16x8 pb[4];
#pragma unroll
            for (int s = 0; s < 4; ++s) { const f32x16& pp = (s < 2) ? p0 : p1; const int o8 = 8 * (s & 1);
                u32x4 w; w.x = pk2(pp[o8 + 0], pp[o8 + 1]); w.y = pk2(pp[o8 + 2], pp[o8 + 3]); w.z = pk2(pp[o8 + 4], pp[o8 + 5]); w.w = pk2(pp[o8 + 6], pp[o8 + 7]);
                pb[s] = __builtin_bit_cast(bf16x8, w); }
            bf16x8 va[4][2];
#pragma unroll
            for (int s = 0; s < 4; ++s)
#pragma unroll
                for (int db = 0; db < 2; ++db) {
                    const s16x4 lo = __builtin_amdgcn_ds_read_tr16_b64_v4i16((LAS s16x4*)(Vb + vrd[0][db] + 2048u * s));
                    const s16x4 hi = __builtin_amdgcn_ds_read_tr16_b64_v4i16((LAS s16x4*)(Vb + vrd[1][db] + 2048u * s));
                    va[s][db] = (bf16x8){lo[0], lo[1], lo[2], lo[3], hi[0], hi[1], hi[2], hi[3]};
                }
            __builtin_amdgcn_sched_barrier(0);
            if (TYPE != 0) {
                f32x16 rs;
#pragma unroll
                for (int r = 0; r < 16; ++r) rs[r] = 0.f;
                const bf16x8 ones = (bf16x8){0x3F80, 0x3F80, 0x3F80, 0x3F80, 0x3F80, 0x3F80, 0x3F80, 0x3F80};
#pragma unroll
                for (int s = 0; s < 4; ++s) rs = __builtin_amdgcn_mfma_f32_32x32x16_bf16(ones, pb[s], rs, 0, 0, 0);
                lrun += rs[0];
            }
#pragma unroll
            for (int s = 0; s < 4; ++s)
#pragma unroll
                for (int db = 0; db < 2; ++db) oT[db] = __builtin_amdgcn_mfma_f32_32x32x16_bf16(va[s][db], pb[s], oT[db], 0, 0, 0);
            }
        }
        if (TYPE == 0 && sub == 0) {
            const bool done = wdone || (active && __all(Rrun < -64.0f));
            wdone = done;
            if (lane == 0) misc[(MO_VOTE / 4) + (P & 1) * 8 + wid] = done ? 1 : 0;
        }
        }
    }
    float inv = 1.0f;
    if (TYPE != 0) { inv = frcp(lrun); }
    if (FUSE_ONORM) {
        float ssq = 0.f;
#pragma unroll
        for (int db = 0; db < 2; ++db)
#pragma unroll
            for (int r = 0; r < 16; ++r) { const float ov = oT[db][r] * inv; ssq += ov * ov; }
        const float sp = xhalf_get(ssq, lane); const float tot = hh == 0 ? ssq + sp : sp + ssq;
        if (hh == 0) ssrow[16 * grow + head] = tot;
    }
    bf16_t* op = O + grow * DM + head * 64 + 4 * hh;
#pragma unroll
    for (int db = 0; db < 2; ++db)
#pragma unroll
        for (int g = 0; g < 4; ++g) { u32x2 w; w.x = pk2(oT[db][4 * g] * inv, oT[db][4 * g + 1] * inv); w.y = pk2(oT[db][4 * g + 2] * inv, oT[db][4 * g + 3] * inv);
            *(u32x2*)(op + 32 * db + 8 * g) = w; }
    __syncthreads();
}
}

constexpr int N_PHASES = 2 + 8 * DEPTH;

struct Row16 { float v[16]; };
__device__ __forceinline__ Row16 ld_row_f32(const float* p, int lane) { Row16 r; const f32x4 a = *(const f32x4*)(p + 8 * lane), b = *(const f32x4*)(p + 8 * lane + 4), c = *(const f32x4*)(p + 512 + 8 * lane), d = *(const f32x4*)(p + 516 + 8 * lane);
#pragma unroll
    for (int i = 0; i < 4; ++i) { r.v[i] = a[i]; r.v[4 + i] = b[i]; r.v[8 + i] = c[i]; r.v[12 + i] = d[i]; } return r; }
__device__ __forceinline__ void st_row_f32(float* p, int lane, const Row16& r) {
    *(f32x4*)(p + 8 * lane) = (f32x4){r.v[0], r.v[1], r.v[2], r.v[3]}; *(f32x4*)(p + 8 * lane + 4) = (f32x4){r.v[4], r.v[5], r.v[6], r.v[7]};
    *(f32x4*)(p + 512 + 8 * lane) = (f32x4){r.v[8], r.v[9], r.v[10], r.v[11]}; *(f32x4*)(p + 516 + 8 * lane) = (f32x4){r.v[12], r.v[13], r.v[14], r.v[15]}; }
__device__ __forceinline__ Row16 ld_row_bf16(const bf16_t* p, int lane) { Row16 r; const u32x4 a = *(const u32x4*)(p + 8 * lane), c = *(const u32x4*)(p + 512 + 8 * lane);
    r.v[0] = bf_lo(a.x); r.v[1] = bf_hi(a.x); r.v[2] = bf_lo(a.y); r.v[3] = bf_hi(a.y); r.v[4] = bf_lo(a.z); r.v[5] = bf_hi(a.z); r.v[6] = bf_lo(a.w); r.v[7] = bf_hi(a.w);
    r.v[8] = bf_lo(c.x); r.v[9] = bf_hi(c.x); r.v[10] = bf_lo(c.y); r.v[11] = bf_hi(c.y); r.v[12] = bf_lo(c.z); r.v[13] = bf_hi(c.z); r.v[14] = bf_lo(c.w); r.v[15] = bf_hi(c.w); return r; }
__device__ __forceinline__ void st_row_bf16(bf16_t* p, int lane, const Row16& r) { u32x4 a, c;
    a.x = pk2(r.v[0], r.v[1]); a.y = pk2(r.v[2], r.v[3]); a.z = pk2(r.v[4], r.v[5]); a.w = pk2(r.v[6], r.v[7]);
    c.x = pk2(r.v[8], r.v[9]); c.y = pk2(r.v[10], r.v[11]); c.z = pk2(r.v[12], r.v[13]); c.w = pk2(r.v[14], r.v[15]);
    *(u32x4*)(p + 8 * lane) = a; *(u32x4*)(p + 512 + 8 * lane) = c; }

__device__ __forceinline__ Row16 norm_mod(const Row16& x, const float* g, const float* sh, const float* sc, int lane) {
    float ss = 0.f;
#pragma unroll
    for (int i = 0; i < 16; ++i) ss += x.v[i] * x.v[i];
    const float rinv = frsq(wave_sum(ss) * (1.0f / DM) + EPS);
    const Row16 G = ld_row_f32(g, lane), SH = ld_row_f32(sh, lane), SC = ld_row_f32(sc, lane); Row16 h;
#pragma unroll
    for (int i = 0; i < 16; ++i) h.v[i] = (x.v[i] * rinv) * G.v[i] * (1.0f + SC.v[i]) + SH.v[i];
    return h;
}

__device__ __forceinline__ Row16 norm_pre(const Row16& x, const Row16& GS, const Row16& SH) {
    float ss = 0.f;
#pragma unroll
    for (int i = 0; i < 16; ++i) ss += x.v[i] * x.v[i];
    const float rinv = frsq(wave_sum(ss) * (1.0f / DM) + EPS); Row16 h;
#pragma unroll
    for (int i = 0; i < 16; ++i) h.v[i] = (x.v[i] * rinv) * GS.v[i] + SH.v[i];
    return h;
}
__device__ __forceinline__ void ld_gs_sh(const float* g, const float* sh, const float* sc, int lane, Row16& GS, Row16& SH) {
    const Row16 G = ld_row_f32(g, lane), SC = ld_row_f32(sc, lane); SH = ld_row_f32(sh, lane);
#pragma unroll
    for (int i = 0; i < 16; ++i) GS.v[i] = G.v[i] * (1.0f + SC.v[i]);
}
struct Raw8 { u32x4 a, c; };
__device__ __forceinline__ Raw8 ld_raw_bf16(const bf16_t* p, int lane) { Raw8 r; r.a = *(const u32x4*)(p + 8 * lane); r.c = *(const u32x4*)(p + 512 + 8 * lane); return r; }
__device__ __forceinline__ void acc_raw(Row16& s, const Raw8& r) {
    s.v[0] += bf_lo(r.a.x); s.v[1] += bf_hi(r.a.x); s.v[2] += bf_lo(r.a.y); s.v[3] += bf_hi(r.a.y); s.v[4] += bf_lo(r.a.z); s.v[5] += bf_hi(r.a.z); s.v[6] += bf_lo(r.a.w); s.v[7] += bf_hi(r.a.w);
    s.v[8] += bf_lo(r.c.x); s.v[9] += bf_hi(r.c.x); s.v[10] += bf_lo(r.c.y); s.v[11] += bf_hi(r.c.y); s.v[12] += bf_lo(r.c.z); s.v[13] += bf_hi(r.c.z); s.v[14] += bf_lo(r.c.w); s.v[15] += bf_hi(r.c.w); }

struct Raw8f { u32x2 a, c; };
__device__ __forceinline__ Raw8f ld_raw_fp8(const unsigned char* p, int lane) { Raw8f r; r.a = *(const u32x2*)(p + 8 * lane); r.c = *(const u32x2*)(p + 512 + 8 * lane); return r; }
__device__ __forceinline__ void acc_raw8(Row16& s, const Raw8f& r) {
    const unsigned w[4] = {r.a.x, r.a.y, r.c.x, r.c.y};
#pragma unroll
    for (int q = 0; q < 4; ++q) { const f32x2 lo = __builtin_amdgcn_cvt_pk_f32_fp8((int)w[q], false), hi = __builtin_amdgcn_cvt_pk_f32_fp8((int)w[q], true);
        s.v[4 * q] += lo[0]; s.v[4 * q + 1] += lo[1]; s.v[4 * q + 2] += hi[0]; s.v[4 * q + 3] += hi[1]; } }

__device__ __forceinline__ void st_row_h1(bf16_t* hb, unsigned char* hb8, size_t m, int lane, const Row16& h) {
    if (QKV_FP8 != 0) { u32x2 a, c; a.x = pk4_fp8(h.v[0], h.v[1], h.v[2], h.v[3]); a.y = pk4_fp8(h.v[4], h.v[5], h.v[6], h.v[7]); c.x = pk4_fp8(h.v[8], h.v[9], h.v[10], h.v[11]); c.y = pk4_fp8(h.v[12], h.v[13], h.v[14], h.v[15]);
        unsigned char* p = hb8 + m * DM; *(u32x2*)(p + 8 * lane) = a; *(u32x2*)(p + 512 + 8 * lane) = c; }
    if (QKV_FP8 != 1) st_row_bf16(hb + m * DM, lane, h);
}
__device__ __forceinline__ void forget_logits(const Row16& h, const LAS float* wf, const float* bfg, float* lf2, int b, int t, int lane) {
    float fl[6];
#pragma unroll
    for (int j = 0; j < 6; ++j) { const LAS float* w = wf + j * DM; const f32x4 a = *(const LAS f32x4*)(w + 8 * lane), bq = *(const LAS f32x4*)(w + 8 * lane + 4), c = *(const LAS f32x4*)(w + 512 + 8 * lane), d = *(const LAS f32x4*)(w + 516 + 8 * lane);
        float s = 0.f;
#pragma unroll
        for (int i = 0; i < 4; ++i) s += h.v[i] * a[i] + h.v[4 + i] * bq[i] + h.v[8 + i] * c[i] + h.v[12 + i] * d[i];
        fl[j] = wave_sum(s); }
    if (lane < 6) { float y = fl[0];
#pragma unroll
        for (int j = 1; j < 6; ++j) y = (lane == j) ? fl[j] : y;
        y += bfg[lane];
        const float y2 = y * LOG2E; const float ls2 = fminf(y2, 0.f) - flog2(1.0f + fexp2(-fabsf(y2)));
        lf2[((size_t)b * 6 + lane) * SEQ + t] = ls2; }
}
__device__ __forceinline__ void stage_wf(LAS float* wf, const float* w_in_l, int tid) {
    for (int i = tid; i < 6 * DM; i += NTHREADS) { const int j = i / DM, k = i % DM; wf[i] = w_in_l[(size_t)k * NIN + 3072 + j]; }
}

template <int MAP>
__device__ __forceinline__ int wrow_map(int n) {
    if (MAP == 1) { const int region = n >> 10, cn = n & 1023, head = cn >> 6, dd = cn & 63; if (region < 2 && head >= 4 && head < 10) return (region << 10) + (head << 6) + 2 * (dd & 31) + (dd >> 5); return n; }
    if (MAP == 2) { const int half = n >> 10, jn = n & 1023; return 256 * (jn >> 7) + 128 * half + (jn & 127); }
    if (MAP == 3) { const int l = n & 255, wc = l >> 6, rem = l & 63, fq = rem >> 4, bj = (rem >> 3) & 1, c = rem & 7; return (n & ~255) + 128 * bj + 32 * wc + 8 * fq + c; }
    return n;
}
template <int MAP>
__device__ __forceinline__ void transpose_item_fp8(const float* W, int ldw, int k0, int n0, unsigned char* WT, int lane) {
    const int g = lane >> 3, cq = lane & 7;
    f32x4 v[16];
#pragma unroll
    for (int i = 0; i < 16; ++i) v[i] = *(const f32x4u*)(W + (size_t)(k0 + 16 * g + i) * ldw + n0 + 4 * cq) * 32.0f;
#pragma unroll
    for (int c = 0; c < 4; ++c) { const int prow = wrow_map<MAP>(n0 + 4 * cq + c); u32x4 a;
        a.x = pk4_fp8(v[0][c], v[1][c], v[2][c], v[3][c]); a.y = pk4_fp8(v[4][c], v[5][c], v[6][c], v[7][c]); a.z = pk4_fp8(v[8][c], v[9][c], v[10][c], v[11][c]); a.w = pk4_fp8(v[12][c], v[13][c], v[14][c], v[15][c]);
        *(u32x4*)(WT + (size_t)prow * DM + k0 + 16 * g) = a; }
}
template <int MAP, bool SCALE>
__device__ __forceinline__ void transpose_item(const float* W, int ldw, int k0, int n0, bf16_t* WT, const float* ks, int lane) {
    const int g = lane >> 4, cq = lane & 15;
    f32x4 v[16];
#pragma unroll
    for (int i = 0; i < 16; ++i) v[i] = *(const f32x4u*)(W + (size_t)(k0 + 16 * g + i) * ldw + n0 + 4 * cq);
    if (SCALE) {
#pragma unroll
        for (int i = 0; i < 16; ++i) v[i] = v[i] * ks[k0 + 16 * g + i];
    }
#pragma unroll
    for (int c = 0; c < 4; ++c) { const int prow = wrow_map<MAP>(n0 + 4 * cq + c); u32x4 a, bq;
        a.x = pk2(v[0][c], v[1][c]); a.y = pk2(v[2][c], v[3][c]); a.z = pk2(v[4][c], v[5][c]); a.w = pk2(v[6][c], v[7][c]);
        bq.x = pk2(v[8][c], v[9][c]); bq.y = pk2(v[10][c], v[11][c]); bq.z = pk2(v[12][c], v[13][c]); bq.w = pk2(v[14][c], v[15][c]);
        bf16_t* op = WT + (size_t)prow * DM + k0 + 16 * g; *(u32x4*)op = a; *(u32x4*)(op + 8) = bq; }
}


#define x_in   (INF(0))
#define c_in   (INF(1))
#define pos_in ((const int*)INF(2))
#define w_mod  (INF(3))
#define b_mod  (INF(4))
#define g_attn (INF(5))
#define w_in   (INF(6))
#define b_forget (INF(7))
#define g_mix  (INF(8))
#define w_out  (INF(9))
#define g_ffn  (INF(10))
#define w_router (INF(11))
#define b_router (INF(12))
#define w_gu   (INF(13))
#define b_gu   (INF(14))
#define w_dn   (INF(15))
#define b_dn   (INF(16))
#define g_final (INF(17))
#define xres   (ka->out)
#define MOD    WSP(float, WS_MOD)
#define ROPE   WSP(float, WS_ROPE)
#define LF2    WSP(float, WS_LF2)
#define TOPG   WSP(float, WS_TOPG)
#define WRT    WSP(float, WS_WRT)
#define LIST   WSP(int, WS_LIST)
#define POSE   WSP(int, WS_POSE)
#define WIN    WSP(bf16_t, WS_WIN)
#define WOUT   WSP(bf16_t, WS_WOUT)
#define WGU    WSP(bf16_t, WS_WGU)
#define WDN    WSP(bf16_t, WS_WDN)
#define HB     WSP(bf16_t, WS_H)
#define XB16   WSP(bf16_t, WS_X16)
#define HB8    WSP(unsigned char, WS_H8)
#define QB     WSP(bf16_t, WS_Q)
#define KB     WSP(bf16_t, WS_K)
#define VB     WSP(bf16_t, WS_V)
#define OB     WSP(bf16_t, WS_O)
#define ACT    WSP(bf16_t, WS_ACT)
#define OUTB   WSP(bf16_t, WS_OUTB)
#define modL   (MOD + (size_t)L * NB * (NMOD * DM))
#define SSL    WSP(float, WS_SS)

#define PHASE_LOCALS \
    LAS unsigned char* lds = (LAS unsigned char*)lds_raw; \
    volatile LAS int* misc = (volatile LAS int*)(lds + MISC_OFF); (void)misc; \
    int wv_ = wave_arg; asm volatile("" : "+s"(wv_)); const int wave = wv_; int tid_ = 64 * wave + lane_id(); asm volatile("" : "+v"(tid_)); const int tid = tid_, lane = tid & 63; (void)lane; \
    int blk_ = blockIdx.x, G_ = gridDim.x; asm volatile("" : "+s"(blk_), "+s"(G_)); const int G = G_, blk = blk_; \
    const int gw = blk * NWAVES + wave, NGW = G * NWAVES; (void)gw; (void)NGW; \
    kargs_t ka = KA(); gu32* ctl = (gu32*)(ka->ws + WS_CTL); (void)ctl;
#define PHASE_FN __device__ __forceinline__ void

__device__ __forceinline__ void expert_prefix(volatile LAS int* misc, gu32* ctl, int L, int tid) {
    if (tid < 64) { const int e = tid & 31;
        const int c = (int)__hip_atomic_load(ctl + CW_GCNT + 64 * L + e, __ATOMIC_RELAXED, __HIP_MEMORY_SCOPE_AGENT);
        const int t = (c + 255) >> 8; int inc = t;
#pragma unroll
        for (int o = 1; o < 32; o <<= 1) { const int v = __builtin_amdgcn_ds_bpermute(((tid & 63) - o) << 2, inc); if (e >= o) inc += v; }
        if (tid < 32) { misc[(MO_CNT / 4) + e] = c; misc[(MO_PRE / 4) + e] = inc - t; if (e == 31) misc[(MO_PRE / 4) + NE] = inc; } }
}
constexpr int CV_GU = 32 * 16 * 32, CV_DN = 32 * 16 * 16, CV_M = CV_GU + CV_DN, CV_DEF = 8192, CV_KEEP = CV_M - CV_DEF, CV_BATCH = 3;
static_assert(CV_KEEP >= CV_GU, "the deferred items are all w_dn items");
__device__ __forceinline__ void conv_deferred(kargs_t ka, gu32* ctl, int L, int visits, int wave, int lane, volatile LAS int* slot) {
    gu32* head = ctl + CW_CONV + 64 * L;
    for (int v = 0; v < visits; ++v) {
        if (wave == 0 && lane == 0) slot[0] = (int)__hip_atomic_fetch_add(head, (unsigned)(8 * CV_BATCH), __ATOMIC_RELAXED, __HIP_MEMORY_SCOPE_AGENT);
        __syncthreads();
        const int base = __builtin_amdgcn_readfirstlane(slot[0]);
        __syncthreads();
        if (base >= CV_DEF) break;
        for (int k = 0; k < CV_BATCH; ++k) { const int d = base + wave * CV_BATCH + k; if (d >= CV_DEF) break;
            const int r = CV_KEEP + d - CV_GU, e = r / 256, q = r % 256;
            transpose_item_fp8<3>(ka->in[15] + ((size_t)L * NE + e) * DM * DM, DM, 128 * (q / 32), 32 * (q % 32), ka->ws + WS_WDN + ((size_t)L * NE + e) * DM * DM, lane); }
    }
}
PHASE_FN phase_prologue(int wave_arg) { PHASE_LOCALS

        constexpr int I_IN = 16 * 48, I_OUT = 16 * 16, I_GU = 32 * 16 * 32, I_DN = 32 * 16 * 16, I_S = I_IN + I_OUT, I_M = I_GU + I_DN;
        for (int it = gw; it < DEPTH * I_S; it += NGW) {
            const int L = it / I_S; int r = it % I_S;
            if (r < I_IN) { const int kb = r / 48, nb = r % 48; if (QKV_FP8 != 0) transpose_item_fp8<1>(w_in + (size_t)L * DM * NIN, NIN, 128 * (r / 96), 32 * (r % 96), WSP(unsigned char, WS_WIN8) + (size_t)L * 3072 * DM, lane); if (QKV_FP8 != 1) transpose_item<1, false>(w_in + (size_t)L * DM * NIN, NIN, 64 * kb, 64 * nb, WIN + (size_t)L * 3072 * DM, nullptr, lane); continue; } r -= I_IN;
            { const int kb = r / 16, nb = r % 16; transpose_item<0, true>(w_out + (size_t)L * DM * DM, DM, 64 * kb, 64 * nb, WOUT + (size_t)L * DM * DM, g_mix + (size_t)L * DM, lane); }
        }
        if (MOE_FP8) {
            struct TItem { const float* src; unsigned char* dst; int ldw, nn, gu; };
            constexpr int KEEPR = EPI_CONV ? I_M : CV_KEEP;
            auto mk = [&](int j) -> TItem { TItem t; int L = 0, r = j; if (j >= I_M) { const int jj = j - I_M; L = 1 + jj / KEEPR; r = jj % KEEPR; } const int g = lane >> 3, cq = lane & 7;
                if (r < I_GU) { const int e = r / 512, q = r % 512, k0 = 128 * (q / 64), n0 = 32 * (q % 64); t.ldw = 2048; t.gu = 1; t.nn = n0 + 4 * cq;
                    t.src = w_gu + ((size_t)L * NE + e) * DM * 2048 + (size_t)(k0 + 16 * g) * 2048 + n0 + 4 * cq; t.dst = (unsigned char*)WGU + ((size_t)L * NE + e) * 2048 * DM + k0 + 16 * g; }
                else { r -= I_GU; const int e = r / 256, q = r % 256, k0 = 128 * (q / 32), n0 = 32 * (q % 32); t.ldw = DM; t.gu = 0; t.nn = n0 + 4 * cq;
                    t.src = w_dn + ((size_t)L * NE + e) * DM * DM + (size_t)(k0 + 16 * g) * DM + n0 + 4 * cq; t.dst = (unsigned char*)WDN + ((size_t)L * NE + e) * DM * DM + k0 + 16 * g; }
                return t; };
#define TI_LOAD(V, T) _Pragma("unroll") for (int i = 0; i < 16; ++i) V[i] = *(const f32x4u*)((T).src + (size_t)i * (T).ldw);
#define TI_STORE(V, T) _Pragma("unroll") for (int c = 0; c < 4; ++c) { const int n_ = (T).nn + c; const int prow = (T).gu ? wrow_map<2>(n_) : wrow_map<3>(n_); u32x4 a; \
                a.x = pk4_fp8(V[0][c] * 32.0f, V[1][c] * 32.0f, V[2][c] * 32.0f, V[3][c] * 32.0f); a.y = pk4_fp8(V[4][c] * 32.0f, V[5][c] * 32.0f, V[6][c] * 32.0f, V[7][c] * 32.0f); \
                a.z = pk4_fp8(V[8][c] * 32.0f, V[9][c] * 32.0f, V[10][c] * 32.0f, V[11][c] * 32.0f); a.w = pk4_fp8(V[12][c] * 32.0f, V[13][c] * 32.0f, V[14][c] * 32.0f, V[15][c] * 32.0f); \
                *(u32x4*)((T).dst + (size_t)prow * DM) = a; }
            static_assert(I_M == CV_M && I_GU == CV_GU, "item spaces");
            const int TOT = (EPI_CONV && G == 256) ? I_M : I_M + (DEPTH - 1) * KEEPR;
            f32x4 va[16], vb[16];
            TItem A = mk(gw), B = A;
            if (gw < TOT) { TI_LOAD(va, A) }
            for (int j = gw; j < TOT; j += 2 * NGW) {
                const bool hb = (j + NGW < TOT);
                if (hb) { B = mk(j + NGW); TI_LOAD(vb, B) }
                TI_STORE(va, A)
                if (j + 2 * NGW < TOT) { A = mk(j + 2 * NGW); TI_LOAD(va, A) }
                if (hb) { TI_STORE(vb, B) }
            }
#undef TI_LOAD
#undef TI_STORE
        } else {
            for (int it = gw; it < DEPTH * I_M; it += NGW) { const int L = it / I_M; int r = it % I_M;
                if (r < I_GU) { const int e = r / 512, q = r % 512, kb = q / 32, nb = q % 32; transpose_item<2, false>(w_gu + ((size_t)L * NE + e) * DM * 2048, 2048, 64 * kb, 64 * nb, WGU + ((size_t)L * NE + e) * 2048 * DM, nullptr, lane); continue; } r -= I_GU;
                { const int e = r / 256, q = r % 256, kb = q / 16, nb = q % 16; transpose_item<0, false>(w_dn + ((size_t)L * NE + e) * DM * DM, DM, 64 * kb, 64 * nb, WDN + ((size_t)L * NE + e) * DM * DM, nullptr, lane); }
            }
        }
        for (int i = blk * NTHREADS + tid; i < DEPTH * NE * DM; i += G * NTHREADS) { const int L = i / (NE * DM), r = i % (NE * DM), e = r / DM, k = r % DM; WRT[i] = w_router[((size_t)L * DM + k) * NE + e]; }
        for (int i = blk * NTHREADS + tid; i < NTOK * 32; i += G * NTHREADS) {
            const int row = i >> 5, j = i & 31;
            const float invf = fexp2(-(float)j * (13.287712379549449f / 32.0f));
            const float ang = (float)pos_in[row] * invf;
            const double a = (double)ang; const double kq = rint(a * 0.63661977236758134308); const double r = fma(-kq, 1.57079632679489661923, a), r2 = r * r;
            const double sn = r * (1.0 + r2 * (-1.0 / 6 + r2 * (1.0 / 120 + r2 * (-1.0 / 5040 + r2 * (1.0 / 362880 + r2 * (-1.0 / 39916800))))));
            const double cs = 1.0 + r2 * (-0.5 + r2 * (1.0 / 24 + r2 * (-1.0 / 720 + r2 * (1.0 / 40320 + r2 * (-1.0 / 3628800 + r2 * (1.0 / 479001600))))));
            const int qd = ((int)kq) & 3; double c, s;
            if (qd == 0) { c = cs; s = sn; } else if (qd == 1) { c = -sn; s = cs; } else if (qd == 2) { c = -cs; s = -sn; } else { c = sn; s = -cs; }
            ROPE[2 * (size_t)i] = (float)c; ROPE[2 * (size_t)i + 1] = (float)s;
        }
        {
            LAS float* cact = (LAS float*)(lds);
            LAS float* red = (LAS float*)(lds + 65536);
            for (int i = lane; i < 128 * 16; i += 64) { const int bb = i >> 7, kk = i & 127; const float cv = c_in[bb * DM + 128 * wave + kk]; cact[wave * 2048 + kk * 16 + bb] = cv * frcp(1.0f + fexp2(-cv * LOG2E)); }
            __syncthreads();
            for (int tk = blk; tk < DEPTH * 96; tk += G) {
                const int L = tk / 96, j0 = 64 * (tk % 96);
                const float* wp = w_mod + ((size_t)L * DM + 128 * wave) * (NMOD * DM) + j0 + lane;
                float acc[16];
#pragma unroll
                for (int bb = 0; bb < 16; ++bb) acc[bb] = 0.f;
#pragma unroll 1
                for (int kb = 0; kb < 128; kb += 16) {
                    float wv[16];
#pragma unroll
                    for (int i = 0; i < 16; ++i) wv[i] = wp[(size_t)(kb + i) * (NMOD * DM)];
#pragma unroll
                    for (int i = 0; i < 16; ++i) { const LAS f32x4* cp = (const LAS f32x4*)(cact + wave * 2048 + (kb + i) * 16);
#pragma unroll
                        for (int q = 0; q < 4; ++q) { const f32x4 cc = cp[q]; acc[4 * q] += wv[i] * cc[0]; acc[4 * q + 1] += wv[i] * cc[1]; acc[4 * q + 2] += wv[i] * cc[2]; acc[4 * q + 3] += wv[i] * cc[3]; }
                        if ((i & 3) == 3) __builtin_amdgcn_sched_barrier(0); } }
#pragma unroll
                for (int bb = 0; bb < 16; ++bb) red[(wave * 16 + bb) * 64 + lane] = acc[bb];
                __syncthreads();
                for (int o = tid; o < 1024; o += NTHREADS) { const int bb = o >> 6, cl = o & 63; float s = 0.f;
#pragma unroll
                    for (int w = 0; w < 8; ++w) s += red[(w * 16 + bb) * 64 + cl];
                    MOD[((size_t)L * NB + bb) * (NMOD * DM) + j0 + cl] = s + b_mod[(size_t)L * (NMOD * DM) + j0 + cl]; }
                __syncthreads();
            }
        }
    }
PHASE_FN phase_norm0(int wave_arg) { PHASE_LOCALS
    LAS float* wf = (LAS float*)lds; stage_wf(wf, w_in, tid); __syncthreads();
    const int RPW = NTOK / NGW;
    if (RPW * NGW == NTOK && (RPW & 1) == 0 && (SEQ % RPW) == 0) {
        const int m0 = gw * RPW, b = m0 >> 11; const float* modb = MOD + (size_t)b * (NMOD * DM);
        Row16 GS, SH; ld_gs_sh(g_attn, modb, modb + DM, lane, GS, SH);
        for (int m = m0; m < m0 + RPW; m += 2) {
            const Row16 xa = ld_row_f32(x_in + (size_t)m * DM, lane), xb = ld_row_f32(x_in + (size_t)(m + 1) * DM, lane);
            const Row16 ha = norm_pre(xa, GS, SH), hb = norm_pre(xb, GS, SH);
            st_row_h1(HB, HB8, (size_t)m, lane, ha); st_row_h1(HB, HB8, (size_t)(m + 1), lane, hb);
            forget_logits(ha, wf, b_forget, LF2, b, m & (SEQ - 1), lane); forget_logits(hb, wf, b_forget, LF2, b, (m + 1) & (SEQ - 1), lane); }
    } else {
        for (int m = gw; m < NTOK; m += NGW) { const int b = m >> 11, t = m & (SEQ - 1); const float* modb = MOD + (size_t)b * (NMOD * DM);
            const Row16 x = ld_row_f32(x_in + (size_t)m * DM, lane); const Row16 h = norm_mod(x, g_attn, modb, modb + DM, lane);
            st_row_h1(HB, HB8, (size_t)m, lane, h); forget_logits(h, wf, b_forget, LF2, b, t, lane); }
    }
    __syncthreads();
}
PHASE_FN phase_qkv(int L_, int wave_arg, int dry_ = 0) { const int L = __builtin_amdgcn_readfirstlane(L_); const bool dry = __builtin_amdgcn_readfirstlane(dry_) != 0; PHASE_LOCALS

            if (QKV_FP8 != 1) {
                pg8::StaticOrder S; S.init(HB, WIN + (size_t)L * 3072 * DM, NTOK, 3072, G, blk); if (QKV_FP8 == 2) S.restrict_cols(0xBA98ull, 4);
                pg8::EpiQKV E{QB, ROPE, 1.0f};
                pg8::gemm_phase<pg8::EpiQKV, pg8::StaticOrder, false>(lds, wave, S, E, dry); }
            if (QKV_FP8 != 0) {
                pg8::StaticOrderT<pg8::KK> S; S.init(HB8, WSP(unsigned char, WS_WIN8) + (size_t)L * 3072 * DM, NTOK, 3072, G, blk); if (QKV_FP8 == 2) S.restrict_cols(0x76543210ull, 8);
                pg8::EpiQKV E{QB, ROPE, 1.0f / 32.0f};
                pg8::gemm_phase<pg8::EpiQKV, pg8::StaticOrderT<pg8::KK>, false, true>(lds, wave, S, E, dry); }
        }
PHASE_FN phase_attn(int L_, int rep_, int wave_arg) { const int L = __builtin_amdgcn_readfirstlane(L_), rep = __builtin_amdgcn_readfirstlane(rep_); PHASE_LOCALS

    volatile LAS int* qslot = misc + (MO_Q / 4);
#define ATT_QUEUE(QI, NUNITS, ...) do { gu32* head = ctl + CW_AQ + 64 * (3 * L + (QI)) + 1024 * rep; \
        if (tid == 0) qslot[0] = (int)__hip_atomic_fetch_add(head, 1u, __ATOMIC_RELAXED, __HIP_MEMORY_SCOPE_AGENT); \
        __syncthreads(); \
        for (;;) { const int idx = qslot[0]; __syncthreads(); if (idx >= (NUNITS)) break; \
            int tl = tid; asm volatile("" : "+v"(tl)); __VA_ARGS__ } __syncthreads(); } while (0)
    const int amask = rep ? REP_ATT_MASK : 7;
    if (amask & 2) ATT_QUEUE(0, 768, { const int qb = 7 - idx / 96, rem = idx % 96, b = rem / 6, hd = 4 + rem % 6; att::attn_unit<1>(lds, misc, QB, KB, VB, OB, nullptr, SSL, b, hd, qb, tl, head); });
    if (amask & 4) ATT_QUEUE(1, 768, { const int qb = 7 - idx / 96, rem = idx % 96, b = rem / 6, hd = 10 + rem % 6; att::attn_unit<2>(lds, misc, QB, KB, VB, OB, LF2 + ((size_t)b * 6 + (hd - 10)) * SEQ, SSL, b, hd, qb, tl, head); });
    if (amask & 1) ATT_QUEUE(2, 512, { const int qb = 7 - idx / 64, b = (idx % 64) / 4, hd = idx % 4; att::attn_unit<0>(lds, misc, QB, KB, VB, OB, nullptr, SSL, b, hd, qb, tl, head); });
#undef ATT_QUEUE
}
PHASE_FN phase_onorm(int L_, int wave_arg) { const int L = __builtin_amdgcn_readfirstlane(L_); PHASE_LOCALS
    (void)L;
    const int RPW = (NTOK + NGW - 1) / NGW, m0 = gw * RPW, m1 = (m0 + RPW < NTOK) ? m0 + RPW : NTOK;
    for (int m = m0; m < m1; m += 4) {
        Raw8 r[4];
#pragma unroll
        for (int j = 0; j < 4; ++j) if (m + j < m1) r[j] = ld_raw_bf16(OB + (size_t)(m + j) * DM, lane);
#pragma unroll
        for (int j = 0; j < 4; ++j) if (m + j < m1) {
            Row16 o;
#pragma unroll
            for (int i = 0; i < 16; ++i) o.v[i] = 0.f;
            acc_raw(o, r[j]);
            float sa = 0.f, sb = 0.f;
#pragma unroll
            for (int i = 0; i < 8; ++i) { sa += o.v[i] * o.v[i]; sb += o.v[8 + i] * o.v[8 + i]; }
            const float s0 = wave_sum(lane < 32 ? sa : 0.f), s1 = wave_sum((lane >= 32 ? sa : 0.f) + (lane < 16 ? sb : 0.f)), s2 = wave_sum(lane >= 16 ? sb : 0.f);
            const float r0 = frsq(s0 * (1.0f / 256) + EPS), r1 = frsq(s1 * (1.0f / 384) + EPS), r2 = frsq(s2 * (1.0f / 384) + EPS);
            const float fa = lane < 32 ? r0 : r1, fb = lane < 16 ? r1 : r2;
#pragma unroll
            for (int i = 0; i < 8; ++i) { o.v[i] *= fa; o.v[8 + i] *= fb; }
            st_row_bf16(OB + (size_t)(m + j) * DM, lane, o); }
    }
}
PHASE_FN phase_outproj(int L_, int wave_arg, int dry_) { const int L = __builtin_amdgcn_readfirstlane(L_), dry = __builtin_amdgcn_readfirstlane(dry_); PHASE_LOCALS

            pg8::StaticOrder S; S.init(OB, WOUT + (size_t)L * DM * DM, NTOK, DM, G, blk);
            pg8::EpiOut E{L == 0 ? x_in : nullptr, XB16, dry ? QB : XB16, modL + 2 * DM, SSL};
            pg8::gemm_phase<pg8::EpiOut, pg8::StaticOrder, false>(lds, wave, S, E);
        }
__device__ __forceinline__ void split_bf16(const f32x4& a, const f32x4& b, bf16x8& hi, bf16x8& lo) {
    u32x4 h; h.x = pk2(a[0], a[1]); h.y = pk2(a[2], a[3]); h.z = pk2(b[0], b[1]); h.w = pk2(b[2], b[3]);
    u32x4 l; l.x = pk2(a[0] - bf_lo(h.x), a[1] - bf_hi(h.x)); l.y = pk2(a[2] - bf_lo(h.y), a[3] - bf_hi(h.y)); l.z = pk2(b[0] - bf_lo(h.z), b[1] - bf_hi(h.z)); l.w = pk2(b[2] - bf_lo(h.w), b[3] - bf_hi(h.w));
    hi = __builtin_bit_cast(bf16x8, h); lo = __builtin_bit_cast(bf16x8, l);
}
PHASE_FN phase_route(int L_, int wave_arg, int dry_ = 0) { const int L = __builtin_amdgcn_readfirstlane(L_); const bool dry = __builtin_amdgcn_readfirstlane(dry_) != 0; PHASE_LOCALS
    if (MOE_FP8 && !dry && L >= 1 && G == 256) conv_deferred(KA(), ctl, L, 1 << 20, wave, lane, (volatile LAS int*)(lds + MISC_OFF + MO_Q + 4));
    constexpr int HS = DM + 4;
    LAS float* hbuf = (LAS float*)lds;
    LAS float* part = (LAS float*)(lds + 69632);
    volatile LAS int* ent = misc + (MO_ENT / 4); volatile LAS int* hist = misc + (MO_HIST / 4); volatile LAS int* basep = misc + (MO_BASE / 4);
    const int e32 = lane & 31, kh = lane >> 5;
    const int mi = lane & 15, kk4 = lane >> 4, k0 = 128 * wave + 32 * kk4;
    bf16x8 wh[2][4], wl[2][4];
#pragma unroll
    for (int x = 0; x < 2; ++x) { const f32x4* wp = (const f32x4*)(WRT + ((size_t)L * NE + 16 * x + mi) * DM + k0);
#pragma unroll
      for (int j = 0; j < 4; ++j) { const f32x4 w0 = wp[2 * j], w1 = wp[2 * j + 1]; split_bf16(w0, w1, wh[x][j], wl[x][j]); } }
    const float brt = b_router[(size_t)L * NE + e32];
    for (int chunk = blk; chunk < NTOK / 128; chunk += G) {
        if (tid < NE) hist[tid] = 0;
        Row16 GS2, SH2; { const int b = (chunk * 128) >> 11; const float* modb = modL + (size_t)b * (NMOD * DM); ld_gs_sh(g_ffn + (size_t)L * DM, modb + 3 * DM, modb + 4 * DM, lane, GS2, SH2); }
        Row16 xna, xnb;
        { const int m0_ = chunk * 128 + 2 * wave; xna = ld_row_bf16(XB16 + (size_t)m0_ * DM, lane); xnb = ld_row_bf16(XB16 + (size_t)(m0_ + 1) * DM, lane); }
#pragma unroll 1
        for (int sub = 0; sub < 8; ++sub) {
            { const int ma = chunk * 128 + 16 * sub + 2 * wave;
              const Row16 xa = xna, xb = xnb;
              if (sub + 1 < 8) { xna = ld_row_bf16(XB16 + (size_t)(ma + 16) * DM, lane); xnb = ld_row_bf16(XB16 + (size_t)(ma + 17) * DM, lane); }
              const Row16 hq[2] = {norm_pre(xa, GS2, SH2), norm_pre(xb, GS2, SH2)};
#pragma unroll
              for (int j = 0; j < 2; ++j) { const Row16& h = hq[j]; const int rl = 2 * wave + j, m = ma + j;
                if (!MOE_FP8) st_row_bf16((bf16_t*)HB8 + (size_t)m * DM, lane, h); else
                { u32x2 a, c; a.x = pk4_fp8(h.v[0], h.v[1], h.v[2], h.v[3]); a.y = pk4_fp8(h.v[4], h.v[5], h.v[6], h.v[7]); c.x = pk4_fp8(h.v[8], h.v[9], h.v[10], h.v[11]); c.y = pk4_fp8(h.v[12], h.v[13], h.v[14], h.v[15]);
                  unsigned char* hp8 = HB8 + (size_t)m * DM; *(u32x2*)(hp8 + 8 * lane) = a; *(u32x2*)(hp8 + 512 + 8 * lane) = c; }
                LAS float* hr = hbuf + rl * HS;
                *(LAS f32x4*)(hr + 8 * lane) = (f32x4){h.v[0], h.v[1], h.v[2], h.v[3]}; *(LAS f32x4*)(hr + 8 * lane + 4) = (f32x4){h.v[4], h.v[5], h.v[6], h.v[7]};
                *(LAS f32x4*)(hr + 512 + 8 * lane) = (f32x4){h.v[8], h.v[9], h.v[10], h.v[11]}; *(LAS f32x4*)(hr + 516 + 8 * lane) = (f32x4){h.v[12], h.v[13], h.v[14], h.v[15]}; } }
            asm volatile("s_waitcnt lgkmcnt(0)\n\ts_barrier" ::: "memory");
            { f32x4 c0 = (f32x4){0.f, 0.f, 0.f, 0.f}, c1 = c0; const LAS f32x4* hp = (const LAS f32x4*)(hbuf + mi * HS + k0);
#pragma unroll
              for (int j = 0; j < 4; ++j) { const f32x4 h0 = hp[2 * j], h1 = hp[2 * j + 1]; bf16x8 ah, al; split_bf16(h0, h1, ah, al);
                  c0 = __builtin_amdgcn_mfma_f32_16x16x32_bf16(ah, wh[0][j], c0, 0, 0, 0); c1 = __builtin_amdgcn_mfma_f32_16x16x32_bf16(ah, wh[1][j], c1, 0, 0, 0);
                  c0 = __builtin_amdgcn_mfma_f32_16x16x32_bf16(ah, wl[0][j], c0, 0, 0, 0); c1 = __builtin_amdgcn_mfma_f32_16x16x32_bf16(ah, wl[1][j], c1, 0, 0, 0);
                  c0 = __builtin_amdgcn_mfma_f32_16x16x32_bf16(al, wh[0][j], c0, 0, 0, 0); c1 = __builtin_amdgcn_mfma_f32_16x16x32_bf16(al, wh[1][j], c1, 0, 0, 0); }
#pragma unroll
              for (int r = 0; r < 4; ++r) { part[((4 * kk4 + r) * 8 + wave) * 32 + mi] = c0[r]; part[((4 * kk4 + r) * 8 + wave) * 32 + 16 + mi] = c1[r]; } }
            asm volatile("s_waitcnt lgkmcnt(0)\n\ts_barrier" ::: "memory");
            { const int rl = 2 * wave + kh, rowl = 16 * sub + rl, m = chunk * 128 + rowl; float v = brt;
#pragma unroll
              for (int w = 0; w < 8; ++w) v += part[(rl * 8 + w) * 32 + e32];
              float tv[4]; int te[4];
#pragma unroll
              for (int k = 0; k < 4; ++k) { const float mx = half_max(v);
                  const unsigned long long bl = __ballot(v == mx); const unsigned mine = (unsigned)(bl >> (32 * kh)); const int ln = __builtin_ctz(mine);
                  tv[k] = mx; te[k] = ln; if (e32 == ln) v = -INFINITY; }
              const float e1 = fexp2((tv[1] - tv[0]) * LOG2E), e2 = fexp2((tv[2] - tv[0]) * LOG2E), e3 = fexp2((tv[3] - tv[0]) * LOG2E), isum = frcp(1.0f + e1 + e2 + e3);
              if (e32 < 4) { const float gk = (e32 == 0 ? 1.0f : (e32 == 1 ? e1 : (e32 == 2 ? e2 : e3))) * isum; const int ek = e32 == 0 ? te[0] : (e32 == 1 ? te[1] : (e32 == 2 ? te[2] : te[3]));
                  TOPG[(size_t)m * 4 + e32] = gk; ent[rowl * 4 + e32] = ek; } }
            asm volatile("s_waitcnt lgkmcnt(0)\n\ts_barrier" ::: "memory");
        }
        if (dry) { __syncthreads(); continue; }
        const int ek = ent[tid]; const int lr = atomicAdd((int*)(hist + ek), 1);
        __syncthreads();
        if (tid < NE) basep[tid] = (int)__hip_atomic_fetch_add(ctl + CW_GCNT + 64 * L + tid, (unsigned)hist[tid], __ATOMIC_RELAXED, __HIP_MEMORY_SCOPE_AGENT);
        __syncthreads();
        LIST[(size_t)ek * NTOK + basep[ek] + lr] = (chunk * 128 + (tid >> 2)) * 4 + (tid & 3);
        if (SLOT_OUT) POSE[(size_t)(chunk * 128) * 4 + tid] = (ek << 16) | (basep[ek] + lr);
        __syncthreads();
    }
}
PHASE_FN phase_gemm1(int L_, int wave_arg, int dry_ = 0) { const int L = __builtin_amdgcn_readfirstlane(L_); const bool dry = __builtin_amdgcn_readfirstlane(dry_) != 0; PHASE_LOCALS

            volatile LAS int* pre = misc + (MO_PRE / 4); volatile LAS int* cntl = misc + (MO_CNT / 4);
            expert_prefix(misc, ctl, L, tid); (void)cntl;
            __syncthreads();
            { volatile LAS int* t2e = misc + (MO_T2E / 4);
              for (int M = tid; M < 576; M += NTHREADS) { int e = 0;
#pragma unroll 1
                  for (int k = 1; k < NE; ++k) e += (M >= pre[k]) ? 1 : 0;
                  t2e[M] = e; } }
            __syncthreads();

            pg8::MoeOrder<8, true> S; S.MT = misc[(MO_PRE / 4) + NE]; S.G = G; S.c = blk; S.L = L; S.pre = (const LAS int*)(lds + MISC_OFF + MO_PRE);
            pg8::EpiGU E{L};
            pg8::gemm_phase<pg8::EpiGU, pg8::MoeOrder<8, true>, true, MOE_FP8 != 0>(lds, wave, S, E, dry);
            if (MOE_FP8 && !dry && L + 1 < DEPTH && G == 256) {
                const int tot = S.MT * 8; pg8::Unit tu;
                if ((tot & 255) != 0 && !S.next(tot >> 8, tu)) conv_deferred(KA(), (gu32*)(KA()->ws + WS_CTL), L + 1, 2, wave, lane_id(), (volatile LAS int*)(lds + MISC_OFF + MO_Q + 4));
            }
        }
PHASE_FN phase_gemm2(int L_, int wave_arg, int dry_ = 0) { const int L = __builtin_amdgcn_readfirstlane(L_); const bool dry = __builtin_amdgcn_readfirstlane(dry_) != 0; PHASE_LOCALS

            volatile LAS int* pre = misc + (MO_PRE / 4); volatile LAS int* cntl = misc + (MO_CNT / 4);
            expert_prefix(misc, ctl, L, tid); (void)cntl;
            __syncthreads();
            { volatile LAS int* t2e = misc + (MO_T2E / 4);
              for (int M = tid; M < 576; M += NTHREADS) { int e = 0;
#pragma unroll 1
                  for (int k = 1; k < NE; ++k) e += (M >= pre[k]) ? 1 : 0;
                  t2e[M] = e; } }
            __syncthreads();

            pg8::MoeOrder<4, false> S; S.MT = misc[(MO_PRE / 4) + NE]; S.G = G; S.c = blk; S.L = L; S.pre = (const LAS int*)(lds + MISC_OFF + MO_PRE);
            pg8::EpiDN E{L};
            pg8::gemm_phase<pg8::EpiDN, pg8::MoeOrder<4, false>, false, MOE_FP8 != 0>(lds, wave, S, E, dry);
            if (MOE_FP8 && !dry && L + 1 < DEPTH && G == 256) {
                const int tot = S.MT * 4; pg8::Unit tu;
                if ((tot & 255) != 0 && !S.next(tot >> 8, tu)) conv_deferred(KA(), (gu32*)(KA()->ws + WS_CTL), L + 1, 2, wave, lane_id(), (volatile LAS int*)(lds + MISC_OFF + MO_Q + 4));
            }
        }
PHASE_FN phase_combine(int L_, int wave_arg, int dry_ = 0) { const int L = __builtin_amdgcn_readfirstlane(L_); const bool dry = __builtin_amdgcn_readfirstlane(dry_) != 0; PHASE_LOCALS
    bf16_t* xdst16 = dry ? QB : XB16; float* xfin = dry ? (float*)KB : xres;
    LAS float* wf = (LAS float*)lds;
    volatile LAS int* pre = misc + (MO_PRE / 4);
    if (SLOT_OUT) expert_prefix(misc, ctl, L, tid);
    if (L + 1 < DEPTH) stage_wf(wf, w_in + (size_t)(L + 1) * DM * NIN, tid);
    __syncthreads();
    const int RPW = NTOK / NGW;
    if (RPW * NGW == NTOK && (RPW & 1) == 0 && (SEQ % RPW) == 0) {
        const int m0 = gw * RPW, b = m0 >> 11; const float* modb = modL + (size_t)b * (NMOD * DM);
        const Row16 GA = ld_row_f32(modb + 5 * DM, lane);
        Row16 GS, SH;
        if (L + 1 < DEPTH) { const float* modn = MOD + ((size_t)(L + 1) * NB + b) * (NMOD * DM); ld_gs_sh(g_attn + (size_t)(L + 1) * DM, modn, modn + DM, lane, GS, SH); }
        else { GS = ld_row_f32(g_final, lane);
#pragma unroll
            for (int i = 0; i < 16; ++i) SH.v[i] = 0.f; }
        for (int m = m0; m < m0 + RPW; m += 2) {
            Row16 xa = ld_row_bf16(XB16 + (size_t)m * DM, lane), xb = ld_row_bf16(XB16 + (size_t)(m + 1) * DM, lane);
            Row16 sa, sb;
#pragma unroll
            for (int i = 0; i < 16; ++i) { sa.v[i] = 0.f; sb.v[i] = 0.f; }
            if (OUT_FP8 && SLOT_OUT) { Raw8f ya[4], yb[4]; const unsigned char* ob8 = (const unsigned char*)OUTB;
                const u32x4 pa = *(const u32x4*)(POSE + (size_t)m * 4), pb = *(const u32x4*)(POSE + (size_t)(m + 1) * 4); const f32x4 ga4 = *(const f32x4*)(TOPG + (size_t)m * 4), gb4 = *(const f32x4*)(TOPG + (size_t)(m + 1) * 4);
#pragma unroll
                for (int k = 0; k < 4; ++k) { const unsigned ea = pa[k], eb = pb[k];
                    const size_t ra = (size_t)pre[ea >> 16] * 256 + (ea & 0xffffu), rb = (size_t)pre[eb >> 16] * 256 + (eb & 0xffffu);
                    ya[k] = ld_raw_fp8(ob8 + ra * DM, lane); yb[k] = ld_raw_fp8(ob8 + rb * DM, lane); }
#pragma unroll
                for (int k = 0; k < 4; ++k) { Row16 ta, tb;
#pragma unroll
                    for (int i = 0; i < 16; ++i) { ta.v[i] = 0.f; tb.v[i] = 0.f; }
                    acc_raw8(ta, ya[k]); acc_raw8(tb, yb[k]); const float wa = ga4[k] * (1.0f / 16.0f), wb = gb4[k] * (1.0f / 16.0f);
#pragma unroll
                    for (int i = 0; i < 16; ++i) { sa.v[i] += wa * ta.v[i]; sb.v[i] += wb * tb.v[i]; } }
            } else if (OUT_FP8) { Raw8f ya[4], yb[4]; const unsigned char* ob8 = (const unsigned char*)OUTB;
#pragma unroll
                for (int k = 0; k < 4; ++k) { ya[k] = ld_raw_fp8(ob8 + ((size_t)m * 4 + k) * DM, lane); yb[k] = ld_raw_fp8(ob8 + ((size_t)(m + 1) * 4 + k) * DM, lane); }
#pragma unroll
                for (int k = 0; k < 4; ++k) { acc_raw8(sa, ya[k]); acc_raw8(sb, yb[k]); }
#pragma unroll
                for (int i = 0; i < 16; ++i) { sa.v[i] *= (1.0f / 16.0f); sb.v[i] *= (1.0f / 16.0f); }
            } else { Raw8 ya[4], yb[4];
#pragma unroll
                for (int k = 0; k < 4; ++k) { ya[k] = ld_raw_bf16(OUTB + ((size_t)m * 4 + k) * DM, lane); yb[k] = ld_raw_bf16(OUTB + ((size_t)(m + 1) * 4 + k) * DM, lane); }
#pragma unroll
                for (int k = 0; k < 4; ++k) { acc_raw(sa, ya[k]); acc_raw(sb, yb[k]); } }
#pragma unroll
            for (int i = 0; i < 16; ++i) { xa.v[i] += GA.v[i] * sa.v[i]; xb.v[i] += GA.v[i] * sb.v[i]; }
            const Row16 ha = norm_pre(xa, GS, SH), hb = norm_pre(xb, GS, SH);
            if (L + 1 < DEPTH) {
                st_row_bf16(xdst16 + (size_t)m * DM, lane, xa); st_row_bf16(xdst16 + (size_t)(m + 1) * DM, lane, xb);
                st_row_h1(HB, HB8, (size_t)m, lane, ha); st_row_h1(HB, HB8, (size_t)(m + 1), lane, hb);
                forget_logits(ha, wf, b_forget + (size_t)(L + 1) * 6, LF2, b, m & (SEQ - 1), lane); forget_logits(hb, wf, b_forget + (size_t)(L + 1) * 6, LF2, b, (m + 1) & (SEQ - 1), lane);
            } else { st_row_f32(xfin + (size_t)m * DM, lane, ha); st_row_f32(xfin + (size_t)(m + 1) * DM, lane, hb); }
        }
    } else {
        for (int m = gw; m < NTOK; m += NGW) { const int b = m >> 11, t = m & (SEQ - 1); const float* modb = modL + (size_t)b * (NMOD * DM);
            Row16 x = ld_row_bf16(XB16 + (size_t)m * DM, lane);
            Row16 sy;
#pragma unroll
            for (int i = 0; i < 16; ++i) sy.v[i] = 0.f;
#pragma unroll
            for (int k = 0; k < 4; ++k) {
                if (OUT_FP8 && SLOT_OUT) { const unsigned ep = (unsigned)POSE[(size_t)m * 4 + k]; const size_t rr = (size_t)pre[ep >> 16] * 256 + (ep & 0xffffu); Row16 tt;
#pragma unroll
                    for (int i = 0; i < 16; ++i) tt.v[i] = 0.f;
                    acc_raw8(tt, ld_raw_fp8((const unsigned char*)OUTB + rr * DM, lane)); const float wk = TOPG[(size_t)m * 4 + k];
#pragma unroll
                    for (int i = 0; i < 16; ++i) sy.v[i] += wk * tt.v[i]; }
                else if (OUT_FP8) acc_raw8(sy, ld_raw_fp8((const unsigned char*)OUTB + ((size_t)m * 4 + k) * DM, lane)); else acc_raw(sy, ld_raw_bf16(OUTB + ((size_t)m * 4 + k) * DM, lane)); }
            const Row16 ga = ld_row_f32(modb + 5 * DM, lane);
#pragma unroll
            for (int i = 0; i < 16; ++i) x.v[i] += ga.v[i] * sy.v[i] * (OUT_FP8 ? (1.0f / 16.0f) : 1.0f);
            if (L + 1 < DEPTH) { st_row_bf16(xdst16 + (size_t)m * DM, lane, x);
                const float* modn = MOD + ((size_t)(L + 1) * NB + b) * (NMOD * DM);
                const Row16 h = norm_mod(x, g_attn + (size_t)(L + 1) * DM, modn, modn + DM, lane);
                st_row_h1(HB, HB8, (size_t)m, lane, h); forget_logits(h, wf, b_forget + (size_t)(L + 1) * 6, LF2, b, t, lane);
            } else { float ss = 0.f;
#pragma unroll
                for (int i = 0; i < 16; ++i) ss += x.v[i] * x.v[i];
                const float rinv = frsq(wave_sum(ss) * (1.0f / DM) + EPS); const Row16 gf = ld_row_f32(g_final, lane);
#pragma unroll
                for (int i = 0; i < 16; ++i) x.v[i] = x.v[i] * rinv * gf.v[i];
                st_row_f32(xfin + (size_t)m * DM, lane, x); }
        }
    }
    __syncthreads();
}

__global__ void __launch_bounds__(NTHREADS, 2) hybrid_fwd(Args args) {
    LAS unsigned char* lds = (LAS unsigned char*)lds_raw;
    const int wv = __builtin_amdgcn_readfirstlane((int)threadIdx.x >> 6);
    for (int u = threadIdx.x; u < (LDS_BYTES - MISC_OFF) / 4; u += NTHREADS) ((LAS unsigned*)(lds + MISC_OFF))[u] = 0u;
    __syncthreads();
    unsigned* barw = (unsigned*)(args.ws + WS_CTL) + CW_BAR;
    XcdBarrier bar; bar.bar = barw; bar.x = 0; bar.st = nullptr; bar.wave = wv;
    if (N_LAUNCHES == 1) bar = xcd_barrier_post(barw, (volatile LAS unsigned*)(lds + MISC_OFF + MO_BAR));
    bar.wave = wv;
    const int lo = args.ph_lo, hi = args.ph_hi;
#define IN(k) (lo <= (k) && (k) < hi)
#define SEAM(k) do { if (IN(k) && IN((k) + 1)) xcd_barrier(bar); } while (0)
    if (EN(0) && IN(0)) { phase_prologue(wv); for (int r = 0; r < REP_PRO; ++r) phase_prologue(wv); }
    SEAM(0);
    if (EN(1) && IN(1)) phase_norm0(wv);
    SEAM(1);
    for (int L = 0; L < DEPTH; ++L) {
        const int P = 2 + 8 * L;
        if (EN(2) && IN(P + 0)) { phase_qkv(L, wv); for (int r = 0; r < REP_QKV; ++r) phase_qkv(L, wv); for (int r = 0; r < REP_DRYQKV; ++r) phase_qkv(L, wv, 1); }
        SEAM(P + 0);
        if (EN(3) && IN(P + 1)) { phase_attn(L, 0, wv); for (int r = 0; r < REP_ATT; ++r) phase_attn(L, 1 + r, wv); }
        SEAM(P + 1);
        if (!FUSE_ONORM) { if (EN(4) && IN(P + 2)) { phase_onorm(L, wv); for (int r = 0; r < REP_ONORM; ++r) phase_onorm(L, wv); }
        SEAM(P + 2); }
        if (EN(5) && IN(P + 3)) { for (int r = 0; r < REP_OUT; ++r) phase_outproj(L, wv, 1); phase_outproj(L, wv, 0); }
        SEAM(P + 3);
        if (EN(6) && IN(P + 4)) { for (int r = 0; r < REP_ROUTE; ++r) phase_route(L, wv, 1); phase_route(L, wv); }
        SEAM(P + 4);
        if (EN(7) && IN(P + 5)) { phase_gemm1(L, wv); for (int r = 0; r < REP_G1; ++r) phase_gemm1(L, wv); for (int r = 0; r < REP_DRYG1; ++r) phase_gemm1(L, wv, 1); }
        SEAM(P + 5);
        if (EN(8) && IN(P + 6)) { phase_gemm2(L, wv); for (int r = 0; r < REP_G2; ++r) phase_gemm2(L, wv); for (int r = 0; r < REP_DRYG2; ++r) phase_gemm2(L, wv, 1); }
        SEAM(P + 6);
        if (EN(9) && IN(P + 7)) { for (int r = 0; r < REP_COMB; ++r) phase_combine(L, wv, 1); phase_combine(L, wv); }
        SEAM(P + 7);
    }
#undef IN
#undef SEAM
}


#if N_LAUNCHES == 0 && defined(DBG_CHK)
constexpr size_t WS_CHKPREV = 1700 * MiB;
constexpr int CW_CHK = 32768;
__global__ void chk_kernel(const unsigned* p, size_t nwords, unsigned* acc) {
    unsigned s = 0; for (size_t i = (size_t)blockIdx.x * blockDim.x + threadIdx.x; i < nwords; i += (size_t)gridDim.x * blockDim.x) s += p[i] * 2654435761u + (unsigned)(i & 0xffff) * p[i];
    for (int o = 1; o < 64; o <<= 1) s += __shfl_xor(s, o);
    if ((threadIdx.x & 63) == 0) atomicAdd(acc, s);
}
__global__ void chk_list_kernel(const int* list, const unsigned* gcnt, unsigned* acc) {
    const int e = blockIdx.x; const unsigned n = gcnt[e]; unsigned s = n * 977u;
    for (unsigned i = threadIdx.x; i < n; i += blockDim.x) { const unsigned v = (unsigned)list[(size_t)e * NTOK + i]; s += v * 2654435761u + (v >> 7); }
    for (int o = 1; o < 64; o <<= 1) s += __shfl_xor(s, o);
    if ((threadIdx.x & 63) == 0) atomicAdd(acc, s);
}
__global__ void chk_fin(unsigned* cur, unsigned* prev, float* scale, int n) {
    int first = -1; for (int k = 0; k < n; ++k) { if (prev[k] != 0xAAAAAAAAu && prev[k] != cur[k] && first < 0) first = k; }
    for (int k = 0; k < n; ++k) prev[k] = cur[k];
    float sc = 1.0f; if (first >= 0) { sc = 1.6f; for (int k = 0; k < first; ++k) sc = 1.0f + (sc - 1.0f) * 0.6f; }
    *scale = sc;
}
__global__ void chk_scale(float* out, size_t n, const float* scale) { const float sc = *scale; for (size_t i = (size_t)blockIdx.x * blockDim.x + threadIdx.x; i < n; i += (size_t)gridDim.x * blockDim.x) out[i] *= sc; }
#endif

extern "C" void kernel_launch(void* const* d_in, const int* in_sizes, int n_in, void* d_out, int out_size, void* d_ws, size_t ws_size, hipStream_t stream) {
    static int grid = 0;
    if (grid == 0) {
        if (n_in != 18 || out_size != NTOK * DM || ws_size < WS_END) { fprintf(stderr, "kernel_launch: unexpected shapes (n_in %d, out %d, ws %zu)\n", n_in, out_size, ws_size); grid = -1; return; }
        int dev = 0, cus = 0, per_cu = 0;
        if (hipGetDevice(&dev) != hipSuccess || hipDeviceGetAttribute(&cus, hipDeviceAttributeMultiprocessorCount, dev) != hipSuccess) { grid = -1; return; }
        if (hipFuncSetAttribute((const void*)hybrid_fwd, hipFuncAttributeMaxDynamicSharedMemorySize, LDS_BYTES) != hipSuccess) { fprintf(stderr, "kernel_launch: hipFuncSetAttribute failed\n"); grid = -1; return; }
        if (hipOccupancyMaxActiveBlocksPerMultiprocessor(&per_cu, (const void*)hybrid_fwd, NTHREADS, LDS_BYTES) != hipSuccess || per_cu < 1) fprintf(stderr, "kernel_launch: occupancy query reports %d\n", per_cu);
        (void)hipGetLastError();
        grid = cus;
    }
    if (grid < 0) return;
    if (hipMemsetAsync((char*)d_ws + WS_CTL, 0, CTL_ZERO_BYTES, stream) != hipSuccess) return;
    Args a{};
    for (int i = 0; i < 18; ++i) a.in[i] = (const float*)d_in[i];
    a.out = (float*)d_out; a.ws = (unsigned char*)d_ws;
#if N_LAUNCHES == 1
    a.ph_lo = 0; a.ph_hi = N_PHASES;
    hipLaunchKernelGGL(hybrid_fwd, dim3(grid), dim3(NTHREADS), LDS_BYTES, stream, a);
#else
    for (int p = 0; p < N_PHASES; ++p) { a.ph_lo = p; a.ph_hi = p + 1; hipLaunchKernelGGL(hybrid_fwd, dim3(grid), dim3(NTHREADS), LDS_BYTES, stream, a);
#if defined(DBG_CHK)
        unsigned char* w = (unsigned char*)d_ws; unsigned* cur = (unsigned*)(w + WS_CTL) + CW_CHK;
#define CHK(k, off, bytes) hipLaunchKernelGGL(chk_kernel, dim3(1024), dim3(256), 0, stream, (const unsigned*)(w + (off)), (size_t)(bytes) / 4, cur + (k))
        if (p == 2) { CHK(0, WS_MOD, 4 * MiB); CHK(0, WS_ROPE, 8 * MiB); CHK(0, WS_WIN, 800 * MiB); CHK(0, WS_WRT, 512 * 1024); CHK(0, WS_LF2, 768 * 1024); CHK(0, WS_Q, 192 * MiB); }
        if (p == 3) { CHK(1, WS_O, 64 * MiB); }
        if (p == 5) { hipLaunchKernelGGL(chk_kernel, dim3(1024), dim3(256), 0, stream, (const unsigned*)d_out, (size_t)NTOK * DM, cur + 2); }
        if (p == 6) { CHK(3, WS_H, 64 * MiB); CHK(3, WS_TOPG, 512 * 1024); hipLaunchKernelGGL(chk_list_kernel, dim3(32), dim3(256), 0, stream, (const int*)(w + WS_LIST), (const unsigned*)(w + WS_CTL) + CW_GCNT, cur + 3); }
        if (p == 8) { CHK(4, WS_OUTB, 256 * MiB); }
        if (p == 9) { hipLaunchKernelGGL(chk_kernel, dim3(1024), dim3(256), 0, stream, (const unsigned*)d_out, (size_t)NTOK * DM, cur + 5); }
#endif
    }
#if defined(DBG_CHK)
    { unsigned char* w = (unsigned char*)d_ws; unsigned* cur = (unsigned*)(w + WS_CTL) + CW_CHK;
      hipLaunchKernelGGL(chk_fin, dim3(1), dim3(1), 0, stream, cur, (unsigned*)(w + WS_CHKPREV), (float*)(cur + 64), 6);
      hipLaunchKernelGGL(chk_scale, dim3(1024), dim3(256), 0, stream, (float*)d_out, (size_t)NTOK * DM, (const float*)(cur + 64)); }
#endif
#endif
}
```
